# Optimizing an MI355X kernel written in HIP

```python
import math
import jax, jax.numpy as jnp
from jax import lax
import numpy as np

D_MODEL = 1024
BATCH = 8
SEQ = 4096
DEPTH = 1

N_META = 16
SB_HEADS = 8
SB_HEAD_DIM = 64
SB_WIDTH = SB_HEADS * SB_HEAD_DIM
CONV_WIDTH = D_MODEL - SB_WIDTH
CONV_KERNEL = 31
MIX_WIDTH = SB_WIDTH + CONV_WIDTH
IN_COLS = 3 * SB_WIDTH + 2 * CONV_WIDTH
Q_BLOCK = 128
N_EXPERTS = 32
TOP_K = 4
D_EXPERT = D_MODEL
SWIGLU_LIMIT = 7.0
SWIGLU_ALPHA = 1.702
EXPERT_BLOCK = 256
EPS = 1e-6

kernel_name = "hymba_stickbreak_conformer_moe"


def rms_norm(x, g):
    xf = x.astype(jnp.float32)
    y = xf * lax.rsqrt(jnp.mean(xf * xf, axis=-1, keepdims=True) + EPS)
    return (y * g.astype(jnp.float32)).astype(x.dtype)


def layer_norm(x, g, b):
    xf = x.astype(jnp.float32)
    mu = jnp.mean(xf, axis=-1, keepdims=True)
    var = jnp.mean(jnp.square(xf - mu), axis=-1, keepdims=True)
    y = (xf - mu) * lax.rsqrt(var + EPS)
    return (y * g.astype(jnp.float32) + b.astype(jnp.float32)).astype(x.dtype)


def stick_breaking_block(q_blk, k, v, q_pos, k_pos):
    z = jnp.einsum("bhqd,bhkd->bhqk", q_blk, k).astype(jnp.float32) * (1.0 / math.sqrt(SB_HEAD_DIM))
    mask = k_pos[None, :] < q_pos[:, None]
    log_beta = jax.nn.log_sigmoid(z)
    log_keep = jnp.where(mask, jax.nn.log_sigmoid(-z), 0.0)
    later = lax.cumsum(log_keep, axis=3, reverse=True) - log_keep
    a = jnp.where(mask, jnp.exp(log_beta + later), 0.0)
    return jnp.einsum("bhqk,bhkd->bhqd", a.astype(v.dtype), v)


def stick_breaking_attention(q, k, v):
    b, h, l, dh = q.shape
    meta_pos = jnp.arange(N_META)
    meta_out = stick_breaking_block(q[:, :, :N_META], k[:, :, :N_META], v[:, :, :N_META], meta_pos, meta_pos)
    n_blocks = (l - N_META) // Q_BLOCK
    k_pos = jnp.arange(l)

    def one_block(i):
        start = N_META + i * Q_BLOCK
        q_blk = lax.dynamic_slice_in_dim(q, start, Q_BLOCK, axis=2)
        q_pos = start + jnp.arange(Q_BLOCK)
        return stick_breaking_block(q_blk, k, v, q_pos, k_pos)

    out = lax.map(one_block, jnp.arange(n_blocks))
    out = jnp.moveaxis(out, 0, 2).reshape(b, h, n_blocks * Q_BLOCK, dh)
    return jnp.concatenate([meta_out, out], axis=2)


def conformer_conv(u, conv_w, conv_b, ln_g, ln_b):
    val, gate = jnp.split(u, 2, axis=-1)
    hcv = val * jax.nn.sigmoid(gate)
    hcv = lax.conv_general_dilated(
        hcv, conv_w.astype(hcv.dtype)[:, None, :],
        window_strides=(1,), padding=[(CONV_KERNEL - 1, 0)],
        dimension_numbers=("NWC", "WIO", "NWC"),
        feature_group_count=CONV_WIDTH) + conv_b
    hcv = layer_norm(hcv, ln_g, ln_b)
    return jax.nn.silu(hcv)


def moe_ffn(h, w_router, b_router, w_up, b_up, w_down, b_down):
    t, d = h.shape
    logits = (h @ w_router + b_router).astype(jnp.float32)
    top_logits, top_idx = lax.top_k(logits, TOP_K)
    gates = jax.nn.softmax(top_logits, axis=-1)
    n_assign = t * TOP_K
    expert_of = top_idx.reshape(-1).astype(jnp.int32)
    token_of = jnp.arange(n_assign, dtype=jnp.int32) // TOP_K
    gate_of = gates.reshape(-1)
    order = jnp.argsort(expert_of)
    e_sorted = expert_of[order]
    counts = jnp.zeros((N_EXPERTS,), jnp.int32).at[expert_of].add(1)
    padded = (counts + EXPERT_BLOCK - 1) // EXPERT_BLOCK * EXPERT_BLOCK
    start = jnp.cumsum(counts) - counts
    pad_end = jnp.cumsum(padded)
    pad_start = pad_end - padded
    dest = pad_start[e_sorted] + jnp.arange(n_assign, dtype=jnp.int32) - start[e_sorted]
    n_blocks = -(-n_assign // EXPERT_BLOCK) + N_EXPERTS
    n_rows = n_blocks * EXPERT_BLOCK
    row_token = jnp.full((n_rows,), t, jnp.int32).at[dest].set(token_of[order])
    row_gate = jnp.zeros((n_rows,), jnp.float32).at[dest].set(gate_of[order])
    block_expert = jnp.minimum(
        jnp.searchsorted(pad_end, jnp.arange(n_blocks, dtype=jnp.int32) * EXPERT_BLOCK, side="right"),
        N_EXPERTS - 1)
    h_pad = jnp.concatenate([h, jnp.zeros((1, d), h.dtype)], axis=0)
    x_rows = h_pad[row_token].reshape(n_blocks, EXPERT_BLOCK, d)

    def expert_block(args):
        xb, e = args
        up = xb @ w_up[e] + b_up[e]
        glu = jnp.minimum(up[:, :D_EXPERT], SWIGLU_LIMIT)
        lin = jnp.clip(up[:, D_EXPERT:], -SWIGLU_LIMIT, SWIGLU_LIMIT)
        act = glu * jax.nn.sigmoid(SWIGLU_ALPHA * glu) * (lin + 1.0)
        return act @ w_down[e] + b_down[e]

    y_rows = lax.map(expert_block, (x_rows, block_expert)).reshape(n_rows, d)
    y = jnp.zeros((t + 1, d), jnp.float32).at[row_token].add(y_rows.astype(jnp.float32) * row_gate[:, None])
    return y[:t].astype(h.dtype)


def hybrid_layer(x, norm1_g, w_in, q_norm_g, k_norm_g, conv_w, conv_b, conv_ln_g, conv_ln_b,
                 attn_out_g, w_out, norm2_g, w_router, b_router, w_up, b_up, w_down, b_down):
    b, l, d = x.shape
    n = rms_norm(x, norm1_g)
    proj = n @ w_in
    q, k, v, u = jnp.split(proj, [SB_WIDTH, 2 * SB_WIDTH, 3 * SB_WIDTH], axis=-1)
    q = rms_norm(q.reshape(b, l, SB_HEADS, SB_HEAD_DIM), q_norm_g).transpose(0, 2, 1, 3)
    k = rms_norm(k.reshape(b, l, SB_HEADS, SB_HEAD_DIM), k_norm_g).transpose(0, 2, 1, 3)
    v = v.reshape(b, l, SB_HEADS, SB_HEAD_DIM).transpose(0, 2, 1, 3)
    sb = stick_breaking_attention(q, k, v).transpose(0, 2, 1, 3)
    sb = rms_norm(sb, attn_out_g).reshape(b, l, SB_WIDTH)
    cv = conformer_conv(u, conv_w, conv_b, conv_ln_g, conv_ln_b)
    x = x + jnp.concatenate([sb, cv], axis=-1) @ w_out
    hn = rms_norm(x, norm2_g).reshape(b * l, d)
    return x + moe_ffn(hn, w_router, b_router, w_up, b_up, w_down, b_down).reshape(b, l, d)


def setup_inputs(seed: int = 0) -> dict:
    key = jax.random.key(seed)
    ks = jax.random.split(key, 20)
    f32 = jnp.float32
    nrm = lambda k, shape, scale: jax.random.normal(k, shape, f32) * scale
    return {
        "x": nrm(ks[0], (BATCH, SEQ, D_MODEL), 1.0),
        "meta_tokens": nrm(ks[1], (N_META, D_MODEL), 1.0),
        "norm1_g": 1.0 + nrm(ks[2], (DEPTH, D_MODEL), 0.01),
        "w_in": nrm(ks[3], (DEPTH, D_MODEL, IN_COLS), D_MODEL ** -0.5),
        "q_norm_g": 1.0 + nrm(ks[4], (DEPTH, SB_HEAD_DIM), 0.01),
        "k_norm_g": 1.0 + nrm(ks[5], (DEPTH, SB_HEAD_DIM), 0.01),
        "conv_w": nrm(ks[6], (DEPTH, CONV_KERNEL, CONV_WIDTH), CONV_KERNEL ** -0.5),
        "conv_b": nrm(ks[7], (DEPTH, CONV_WIDTH), 0.01),
        "conv_ln_g": 1.0 + nrm(ks[8], (DEPTH, CONV_WIDTH), 0.01),
        "conv_ln_b": nrm(ks[9], (DEPTH, CONV_WIDTH), 0.01),
        "attn_out_g": 1.0 + nrm(ks[10], (DEPTH, SB_HEADS, SB_HEAD_DIM), 0.01),
        "w_out": nrm(ks[11], (DEPTH, MIX_WIDTH, D_MODEL), MIX_WIDTH ** -0.5),
        "norm2_g": 1.0 + nrm(ks[12], (DEPTH, D_MODEL), 0.01),
        "w_router": nrm(ks[13], (DEPTH, D_MODEL, N_EXPERTS), D_MODEL ** -0.5),
        "b_router": nrm(ks[14], (DEPTH, N_EXPERTS), 0.01),
        "w_up": nrm(ks[15], (DEPTH, N_EXPERTS, D_MODEL, 2 * D_EXPERT), D_MODEL ** -0.5),
        "b_up": nrm(ks[16], (DEPTH, N_EXPERTS, 2 * D_EXPERT), 0.01),
        "w_down": nrm(ks[17], (DEPTH, N_EXPERTS, D_EXPERT, D_MODEL), D_EXPERT ** -0.5),
        "b_down": nrm(ks[18], (DEPTH, N_EXPERTS, D_MODEL), 0.01),
    }


def reference(x, meta_tokens, norm1_g, w_in, q_norm_g, k_norm_g, conv_w, conv_b, conv_ln_g,
              conv_ln_b, attn_out_g, w_out, norm2_g, w_router, b_router, w_up, b_up, w_down, b_down):
    b = x.shape[0]
    meta = jnp.broadcast_to(meta_tokens.astype(x.dtype)[None], (b, N_META, x.shape[-1]))
    h = jnp.concatenate([meta, x], axis=1)
    for layer in range(DEPTH):
        h = hybrid_layer(h, norm1_g[layer], w_in[layer], q_norm_g[layer], k_norm_g[layer],
                         conv_w[layer], conv_b[layer], conv_ln_g[layer], conv_ln_b[layer],
                         attn_out_g[layer], w_out[layer], norm2_g[layer], w_router[layer],
                         b_router[layer], w_up[layer], b_up[layer], w_down[layer], b_down[layer])
    return h[:, N_META:]
```

```cpp
#include <hip/hip_runtime.h>
#include <cstdio>
#include <cstdint>

#ifndef MK_N_LAUNCHES
#define MK_N_LAUNCHES 1
#endif
#ifndef ATTN_EARLY
#define ATTN_EARLY 1
#endif

#define LAS __attribute__((address_space(3)))
#define GAS __attribute__((address_space(1)))
typedef unsigned short bf16;
typedef short bf16x8 __attribute__((ext_vector_type(8)));
typedef float f32x2 __attribute__((ext_vector_type(2)));
typedef float f32x4 __attribute__((ext_vector_type(4)));
typedef float f32x16 __attribute__((ext_vector_type(16)));
typedef unsigned u32x2 __attribute__((ext_vector_type(2)));
typedef unsigned u32x4 __attribute__((ext_vector_type(4)));
typedef GAS unsigned gu32;

constexpr int NB = 8, SEQ = 4096, DM = 1024, NTOK = NB * SEQ;
constexpr int NMETA = 16, LPAD = 16, LP = LPAD + NMETA + SEQ;
constexpr int NH = 8, HD = 64, SBW = 512, CW = 512, CKW = 31, INC = 2560;
constexpr int NE = 32, TOPK = 4, DE = 1024, CAP = NTOK;
constexpr int MAXROWS = NTOK * TOPK + NE * 256;
constexpr float EPS = 1e-6f;
constexpr float LOG2E = 1.4426950408889634f;
constexpr float QSCALE = 0.125f * LOG2E;
constexpr float SW_LIMIT = 7.0f, SW_ALPHA = 1.702f;
constexpr float ATTN_CUT = 1e-30f;

constexpr size_t MiB = 1u << 20;
constexpr size_t WS_CTL = 0, CTL_ZERO_BYTES = 1 * MiB;
constexpr size_t WS_WIN = 1 * MiB, WS_WO = 6 * MiB, WS_WD = 8 * MiB, WS_WUP = 72 * MiB;
constexpr size_t WS_NM = 200 * MiB;
constexpr size_t WS_Q = 264 * MiB, WS_K = 296 * MiB, WS_VT = 329 * MiB, WS_HCV = 362 * MiB;
constexpr size_t WS_ACT = 395 * MiB;
constexpr size_t WS_RTOK = 667 * MiB, WS_RGATE = 671 * MiB, WS_TSLOT = 675 * MiB, WS_END = 676 * MiB;
constexpr size_t WS_HN = WS_Q;
constexpr size_t WS_Y = WS_WUP;
static_assert(WS_Y + (size_t)MAXROWS * 2048 <= WS_HCV && WS_ACT + (size_t)MAXROWS * 2048 <= WS_RTOK, "ws map");
constexpr int CW_TMO = 0, CW_BAR = 4096, CW_CNT = 8192;

constexpr int RING_BYTES = 131072;
constexpr int LDSCTL_OFF = RING_BYTES, MISC_OFF = LDSCTL_OFF + 320, AUX_OFF = LDSCTL_OFF + 512;
constexpr int A_TPRE = 0, A_CNT = 256, A_HIST = 384, A_BASE = 512, A_RED = 640, A_TOT = 1664, A_SELE = 1792, A_SELG = 3840, A_RANK = 5888, A_IDX = 8192;
constexpr int MAXU = 17;
constexpr int LDS_BYTES = AUX_OFF + A_IDX + MAXU * 1024;
static_assert(LDS_BYTES <= 163840, "LDS");
constexpr int NWAVES = 8;

#define LDS_WAIT() asm volatile("s_waitcnt lgkmcnt(0)" ::: "memory")
#define VM_WAIT() asm volatile("s_waitcnt vmcnt(0)" ::: "memory")
#define RLX_AGENT __ATOMIC_RELAXED, __HIP_MEMORY_SCOPE_AGENT

__device__ __forceinline__ unsigned cvt_pk_bf16(float lo, float hi) { unsigned r; asm volatile("v_cvt_pk_bf16_f32 %0, %1, %2" : "=v"(r) : "v"(lo), "v"(hi)); return r; }
__device__ __forceinline__ float bf2f(bf16 b) { return __uint_as_float(((unsigned)b) << 16); }
__device__ __forceinline__ bf16 f2bf(float f) { return (bf16)(cvt_pk_bf16(f, 0.f) & 0xffffu); }
__device__ __forceinline__ float fast_rcp(float x) { return __builtin_amdgcn_rcpf(x); }
__device__ __forceinline__ float fast_exp2(float x) { return __builtin_amdgcn_exp2f(x); }
__device__ __forceinline__ float sigmoidf_(float x) { return fast_rcp(1.0f + fast_exp2(-x * LOG2E)); }
__device__ __forceinline__ float wave_sum(float v) {
#pragma unroll
    for (int o = 1; o < 64; o <<= 1) v += __shfl_xor(v, o);
    return v;
}

#define XB_TMO      128
#define XB_XCNT(j)  (256  + 64 * (j))
#define XB_XSUB(j)  (1280 + 64 * (j))
#define XB_XGEN(j)  (2304 + 64 * (j))
#define XB_TOP      3328
#define XB_TOPGEN   3392
#define XCD_BAR_WORDS 3456
#define XB_SPIN_CAP (1u << 18)
__device__ __forceinline__ unsigned xb_ld(unsigned* p)              { return __hip_atomic_load(p, __ATOMIC_RELAXED, __HIP_MEMORY_SCOPE_AGENT); }
__device__ __forceinline__ unsigned xb_add(unsigned* p, unsigned v) { return __hip_atomic_fetch_add(p, v, __ATOMIC_RELAXED, __HIP_MEMORY_SCOPE_AGENT); }
__device__ __forceinline__ unsigned xb_xcc_id() { return (unsigned)__builtin_amdgcn_s_getreg((3 << 11) | 20) & 0xFu; }
#define XB_SPIN(cond, bar) do { unsigned _sp = 0; while (cond) { __builtin_amdgcn_s_sleep(1); \
    if ((++_sp & 255u) == 0u) { if (xb_ld(&(bar)[XB_TMO])) break; if (_sp > XB_SPIN_CAP) { atomicAdd(&(bar)[XB_TMO], 1u); break; } } } } while (0)
struct XcdBarrier { unsigned* bar; unsigned x; volatile LAS unsigned* st; };
__device__ __forceinline__ XcdBarrier xcd_barrier_post(unsigned* bar, volatile LAS unsigned* st) {
    XcdBarrier b; b.bar = bar; b.x = xb_xcc_id(); b.st = st;
    if (threadIdx.x == 0) (void)xb_add(&bar[XB_XCNT(b.x)], 1u);
    return b;
}
__device__ __forceinline__ void xcd_barrier_complete(unsigned* bar, unsigned x, unsigned& nloc, unsigned& nx) {
    const unsigned G = gridDim.x * gridDim.y * gridDim.z;
    unsigned sum, cnt, mine, sp = 0u;
    for (;;) {
        sum = 0u; cnt = 0u; mine = 0u;
#pragma unroll
        for (unsigned j = 0; j < 16; ++j) { const unsigned c = xb_ld(&bar[XB_XCNT(j)]); sum += c; cnt += (c > 0u) ? 1u : 0u; mine = (j == x) ? c : mine; }
        if (sum == G) break;
        __builtin_amdgcn_s_sleep(1);
        if ((++sp & 255u) == 0u) { if (xb_ld(&bar[XB_TMO])) break; if (sp > XB_SPIN_CAP) { atomicAdd(&bar[XB_TMO], 1u); break; } }
    }
    nloc = mine > 0u ? mine : 1u; nx = cnt > 0u ? cnt : 1u;
}
__device__ __forceinline__ void xcd_barrier(const XcdBarrier& b) {
    asm volatile("s_waitcnt vmcnt(0)" ::: "memory");
    __syncthreads();
    if (threadIdx.x == 0) {
        unsigned* bar = b.bar;
        __builtin_amdgcn_s_waitcnt(0);
        unsigned nloc = b.st[0], nx = b.st[1];
        if (nloc == 0u) { xcd_barrier_complete(bar, b.x, nloc, nx); b.st[0] = nloc; b.st[1] = nx; }
        const unsigned old = xb_add(&bar[XB_XSUB(b.x)], 1u);
        const unsigned gen = old / nloc;
        if (old + 1u == (gen + 1u) * nloc) {
            __builtin_amdgcn_fence(__ATOMIC_RELEASE, "agent");
            asm volatile("s_waitcnt vmcnt(0)" ::: "memory");
            const unsigned og = xb_add(&bar[XB_TOP], 1u);
            const unsigned tg = og / nx;
            if (og + 1u == (tg + 1u) * nx) xb_add(&bar[XB_TOPGEN], 1u);
            else XB_SPIN(xb_ld(&bar[XB_TOPGEN]) == tg, bar);
            __builtin_amdgcn_fence(__ATOMIC_ACQUIRE, "agent");
            xb_add(&bar[XB_XGEN(b.x)], 1u);
            asm volatile("s_waitcnt vmcnt(0)" ::: "memory");
        } else {
            XB_SPIN(xb_ld(&bar[XB_XGEN(b.x)]) == gen, bar);
            __builtin_amdgcn_fence(__ATOMIC_ACQUIRE, "agent");
            asm volatile("s_waitcnt vmcnt(0)" ::: "memory");
        }
    }
    __syncthreads();
}

namespace pg8 {
constexpr int BM = 256, BK = 64, HALF = 128, HTB = HALF * BK * 2, STAGE_BYTES = 8 * HTB, NXCD = 8, WGM = 8;
__device__ __forceinline__ int lds_byte(int r, int c) { const int st = (r >> 4) * 2 + (c >> 5), rr = r & 15, cc = c & 31, ob = rr * 64 + cc * 2; return st * 1024 + (ob ^ (((ob >> 9) & 1) << 5)); }
__device__ __forceinline__ void stage_rc(int b, int& R, int& C) { const int st = b / 1024, sb = b % 1024, swz = sb ^ (((sb >> 9) & 1) << 5); R = (st >> 1) * 16 + swz / 64; C = (st & 1) * 32 + (swz % 64) / 2; }
__device__ __forceinline__ int perm32(int rho) { const int n = rho >> 4, i = rho & 15; return 8 * (i >> 2) + 4 * n + (i & 3); }

struct Unit { int pm, pn, e, rt; };

struct StaticSched {
    int nM, nN, nwg, G, c; unsigned K2; const char* Bt;
    __device__ void init(int M, int N, int K, const void* Bt_, int G_, int c_) { nM = M / BM; nN = N / BM; nwg = nM * nN; G = G_; c = c_; K2 = (unsigned)K * 2u; Bt = (const char*)Bt_; }
    __device__ __forceinline__ bool next(int i, Unit& u) const {
        const long L = (long)i * G + c; if (L >= nwg) return false;
        int wgid = (int)L; { const int q = nwg / NXCD, r = nwg % NXCD, xcd = wgid % NXCD, off = wgid / NXCD; wgid = (xcd < r ? xcd * (q + 1) : r * (q + 1) + (xcd - r) * q) + off; }
        const int nig = WGM * nN, gid = wgid / nig, fm = gid * WGM, gsz = (nM - fm) < WGM ? (nM - fm) : WGM;
        u.pm = fm + ((wgid % nig) % gsz); u.pn = (wgid % nig) / gsz; u.e = 0; u.rt = 0; return true;
    }
    __device__ __forceinline__ unsigned aoff(int, const Unit& u, int row) const { return (unsigned)(u.pm * BM + row) * K2; }
    __device__ __forceinline__ const char* bptr(const Unit& u) const { return Bt + (size_t)u.pn * BM * K2; }
};
template <bool GATHER> struct MoeSched {
    int G, v, NT, ntot; unsigned K2; const char* Bt; size_t bstride; const LAS int* tpre; const LAS unsigned* idx;
    __device__ __forceinline__ bool next(int i, Unit& u) const {
        const int U = i * G + v; if (U >= ntot * NT) return false;
        const int rtg = U / NT; u.pm = rtg; u.pn = U - rtg * NT;
        int lo = 0, hi = NE;
#pragma unroll
        for (int s = 0; s < 5; ++s) { const int mid = (lo + hi) >> 1; const int t = __builtin_amdgcn_readfirstlane(tpre[mid]); if (rtg >= t) lo = mid; else hi = mid; }
        u.e = lo; u.rt = rtg - __builtin_amdgcn_readfirstlane(tpre[lo]); return true;
    }
    __device__ __forceinline__ unsigned aoff(int i, const Unit& u, int row) const { if (GATHER) return idx[i * 256 + row]; return (unsigned)(u.pm * BM + row) * K2; }
    __device__ __forceinline__ const char* bptr(const Unit& u) const { return Bt + (size_t)u.e * bstride + (size_t)u.pn * BM * K2; }
};

template <class Epi, class Sched>
__device__ __forceinline__ void gemm_phase(LAS unsigned char* lds, const char* Abase, const int K, const Sched& S, const Epi& E, const int tid) {
    const int wid = __builtin_amdgcn_readfirstlane(tid >> 6), lane = tid & 63, wr = wid >> 2, wc = wid & 3, fr = lane & 15, fq = lane >> 4;
    const int nt = K / BK;
    int Rr[2]; unsigned colA[2], voffB[2];
#pragma unroll
    for (int i = 0; i < 2; ++i) { int R, C; stage_rc(tid * 16 + i * 8192, R, C); const int Rb = Epi::PERM ? ((R & ~31) + perm32(R & 31)) : R;
        Rr[i] = R; colA[i] = (unsigned)C * 2u; voffB[i] = (unsigned)(Rb * K + C) * 2u; }
    const unsigned kstep = (unsigned)(BK * 2);
    const size_t hstep = (size_t)HALF * K * 2;
    const unsigned ldsw = (unsigned)wid * 1024u;
    const int aoff = lds_byte(wr * 64 + fr, fq * 8), boff = lds_byte(wc * 32 + fr, fq * 8);
#define PG8_SA(b, h) (((b) * 2 + (h)) * HTB)
#define PG8_SB(b, h) ((4 + (b) * 2 + (h)) * HTB)
#define PG8_STAGEB(bufoff, gbase) do { _Pragma("unroll") for (int _i = 0; _i < 2; ++_i) \
        __builtin_amdgcn_global_load_lds((const unsigned*)((const char*)(gbase) + voffB[_i]), (LAS unsigned*)(lds + (bufoff) + ldsw + _i * 8192), 16, 0, 0); } while (0)
#define PG8_STAGEA(bufoff, offs, kadd) do { _Pragma("unroll") for (int _i = 0; _i < 2; ++_i) \
        __builtin_amdgcn_global_load_lds((const unsigned*)(Abase + (size_t)((offs)[_i] + (unsigned)(kadd))), (LAS unsigned*)(lds + (bufoff) + ldsw + _i * 8192), 16, 0, 0); } while (0)
#define PG8_LDA(dst, b, h) do { _Pragma("unroll") for (int m = 0; m < 4; ++m) _Pragma("unroll") for (int k = 0; k < 2; ++k) dst[m][k] = *(const LAS bf16x8*)(lds + PG8_SA(b, h) + aoff + m * 2048 + k * 1024); } while (0)
#define PG8_LDB(dst, b, h) do { _Pragma("unroll") for (int n = 0; n < 2; ++n) _Pragma("unroll") for (int k = 0; k < 2; ++k) dst[n][k] = *(const LAS bf16x8*)(lds + PG8_SB(b, h) + boff + n * 2048 + k * 1024); } while (0)
#define PG8_MMA(ai, bj, At, Bt) do { __builtin_amdgcn_s_setprio(1); _Pragma("unroll") for (int m = 0; m < 4; ++m) _Pragma("unroll") for (int n = 0; n < 2; ++n) _Pragma("unroll") for (int k = 0; k < 2; ++k) \
        acc[ai][bj][m][n] = __builtin_amdgcn_mfma_f32_16x16x32_bf16(Bt[n][k], At[m][k], acc[ai][bj][m][n], 0, 0, 0); __builtin_amdgcn_s_setprio(0); } while (0)
#define PG8_WAIT_V(n) asm volatile("s_waitcnt vmcnt(" #n ")" ::: "memory")
#define PG8_WAIT_L(n) asm volatile("s_waitcnt lgkmcnt(" #n ")" ::: "memory")
#define PG8_BAR __builtin_amdgcn_s_barrier()
#define PG8_SCHED __builtin_amdgcn_sched_barrier(0)
    Unit cur, nxt; int ui = 0;
    if (!S.next(0, cur)) return;
    f32x4 acc[2][2][4][2];
#pragma unroll
    for (int a = 0; a < 2; ++a)
#pragma unroll
        for (int b = 0; b < 2; ++b)
#pragma unroll
            for (int m = 0; m < 4; ++m)
#pragma unroll
                for (int n = 0; n < 2; ++n) acc[a][b][m][n] = (f32x4){0.f, 0.f, 0.f, 0.f};
    bf16x8 At[4][2], B0[2][2], B1[2][2];
    unsigned ca0[2], ca1[2], na0[2], na1[2];
#pragma unroll
    for (int i = 0; i < 2; ++i) { ca0[i] = S.aoff(0, cur, Rr[i]) + colA[i]; ca1[i] = S.aoff(0, cur, HALF + Rr[i]) + colA[i]; }
    const char* cB = S.bptr(cur);
    PG8_STAGEB(PG8_SB(0, 0), cB); PG8_STAGEB(PG8_SB(0, 1), cB + hstep); PG8_STAGEA(PG8_SA(0, 0), ca0, 0); PG8_STAGEA(PG8_SA(0, 1), ca1, 0);
    if (wr == 1) PG8_BAR;
    PG8_WAIT_V(2); PG8_BAR;
    PG8_STAGEB(PG8_SB(1, 0), cB + kstep); PG8_STAGEA(PG8_SA(1, 0), ca0, kstep); PG8_STAGEB(PG8_SB(1, 1), cB + hstep + kstep);
    PG8_WAIT_V(6); PG8_BAR;
    for (;;) {
        const bool has_next = S.next(ui + 1, nxt);
        const char* nB = has_next ? S.bptr(nxt) : cB;
#pragma unroll
        for (int i = 0; i < 2; ++i) { na0[i] = has_next ? S.aoff(ui + 1, nxt, Rr[i]) + colA[i] : ca0[i]; na1[i] = has_next ? S.aoff(ui + 1, nxt, HALF + Rr[i]) + colA[i] : ca1[i]; }
        for (int t = 0; t < nt; t += 2) {
            const bool last = (t == nt - 2);
            const unsigned k1 = (unsigned)(t + 1) * kstep, k2 = last ? 0u : (unsigned)(t + 2) * kstep;
            unsigned o20[2], o21[2];
#pragma unroll
            for (int i = 0; i < 2; ++i) { o20[i] = last ? na0[i] : ca0[i]; o21[i] = last ? na1[i] : ca1[i]; }
            const char* b2 = last ? nB : cB + (size_t)(t + 2) * kstep; const char* b3 = b2 + kstep;
            PG8_LDB(B0, 0, 0); PG8_LDB(B1, 0, 1); PG8_SCHED; PG8_LDA(At, 0, 0); PG8_STAGEA(PG8_SA(1, 1), ca1, k1);
            PG8_WAIT_V(8); PG8_WAIT_L(0); PG8_BAR; PG8_MMA(0, 0, At, B0); PG8_MMA(0, 1, At, B1); PG8_BAR; PG8_SCHED;
            PG8_LDA(At, 0, 1); PG8_STAGEB(PG8_SB(0, 0), b2); PG8_STAGEB(PG8_SB(0, 1), b2 + hstep); PG8_STAGEA(PG8_SA(0, 0), o20, k2);
            PG8_WAIT_V(8); PG8_WAIT_L(0); PG8_BAR; PG8_MMA(1, 0, At, B0); PG8_MMA(1, 1, At, B1); PG8_BAR; PG8_SCHED;
            PG8_LDB(B0, 1, 0); PG8_LDB(B1, 1, 1); PG8_SCHED; PG8_LDA(At, 1, 0); PG8_STAGEA(PG8_SA(0, 1), o21, k2);
            PG8_WAIT_V(8); PG8_WAIT_L(0); PG8_BAR; PG8_MMA(0, 0, At, B0); PG8_MMA(0, 1, At, B1); PG8_BAR; PG8_SCHED;
            PG8_LDA(At, 1, 1); PG8_STAGEB(PG8_SB(1, 0), b3); PG8_STAGEB(PG8_SB(1, 1), b3 + hstep); PG8_STAGEA(PG8_SA(1, 0), o20, k2 + kstep);
            PG8_WAIT_V(8); PG8_WAIT_L(0); PG8_BAR; PG8_MMA(1, 0, At, B0); PG8_MMA(1, 1, At, B1); PG8_BAR; PG8_SCHED;
        }
        if (wr == 0) PG8_BAR;
        E(acc, cur, wr, wc, fr, fq);
        if (!has_next) break;
#pragma unroll
        for (int a = 0; a < 2; ++a)
#pragma unroll
            for (int b = 0; b < 2; ++b)
#pragma unroll
                for (int m = 0; m < 4; ++m)
#pragma unroll
                    for (int n = 0; n < 2; ++n) acc[a][b][m][n] = (f32x4){0.f, 0.f, 0.f, 0.f};
        cur = nxt; cB = nB; ++ui;
#pragma unroll
        for (int i = 0; i < 2; ++i) { ca0[i] = na0[i]; ca1[i] = na1[i]; }
        if (wr == 1) PG8_BAR;
    }
    PG8_WAIT_V(0);
    PG8_BAR;
#undef PG8_SA
#undef PG8_SB
#undef PG8_STAGEA
#undef PG8_STAGEB
#undef PG8_LDA
#undef PG8_LDB
#undef PG8_MMA
#undef PG8_WAIT_V
#undef PG8_WAIT_L
#undef PG8_BAR
#undef PG8_SCHED
}

struct EpiIn {
    static constexpr bool PERM = true;
    bf16 *Q, *Kh, *VT, *HCV; const float *qg, *kg;
    __device__ __forceinline__ void operator()(const f32x4 (&acc)[2][2][4][2], const Unit& u, int wr, int wc, int fr, int fq) const {
        const int pn = u.pn;
        const int row0 = u.pm * BM + wr * 64 + fr;
        if (pn < 4) {
            const bool isq = pn < 2; const float* g = isq ? qg : kg; const float sc = isq ? QSCALE : 1.0f;
            const int head = 4 * (pn & 1) + wc;
            f32x4 gv[2][2];
#pragma unroll
            for (int bj = 0; bj < 2; ++bj)
#pragma unroll
                for (int n = 0; n < 2; ++n) gv[bj][n] = *(const f32x4*)(g + 32 * bj + 8 * fq + 4 * n) * sc;
#pragma unroll
            for (int ai = 0; ai < 2; ++ai)
#pragma unroll
                for (int m = 0; m < 4; ++m) {
                    float ss = 0.f;
#pragma unroll
                    for (int bj = 0; bj < 2; ++bj)
#pragma unroll
                        for (int n = 0; n < 2; ++n) { const f32x4 x = acc[ai][bj][m][n]; ss += (x[0] * x[0] + x[1] * x[1]) + (x[2] * x[2] + x[3] * x[3]); }
                    ss += __shfl_xor(ss, 16); ss += __shfl_xor(ss, 32);
                    const float rs = __builtin_amdgcn_rsqf(ss * (1.0f / 64.0f) + EPS);
                    const int row = row0 + ai * HALF + m * 16, b = row >> 12, t = row & 4095;
                    bf16* dst = isq ? Q + ((size_t)(b * NH + head) * SEQ + t) * HD : Kh + ((size_t)(b * NH + head) * LP + 32 + t) * HD;
#pragma unroll
                    for (int bj = 0; bj < 2; ++bj) { const f32x4 v0 = acc[ai][bj][m][0] * rs * gv[bj][0], v1 = acc[ai][bj][m][1] * rs * gv[bj][1];
                        u32x4 w; w.x = cvt_pk_bf16(v0[0], v0[1]); w.y = cvt_pk_bf16(v0[2], v0[3]); w.z = cvt_pk_bf16(v1[0], v1[1]); w.w = cvt_pk_bf16(v1[2], v1[3]);
                        *(u32x4*)(dst + 32 * bj + 8 * fq) = w; }
                }
        } else if (pn < 6) {
            const int head = 4 * (pn & 1) + wc;
#pragma unroll
            for (int ai = 0; ai < 2; ++ai)
#pragma unroll
                for (int m = 0; m < 4; ++m) {
                    const int row = row0 + ai * HALF + m * 16, b = row >> 12, t = row & 4095;
                    bf16* dst = VT + ((size_t)(b * NH + head) * HD) * LP + 32 + t;
#pragma unroll
                    for (int bj = 0; bj < 2; ++bj)
#pragma unroll
                        for (int n = 0; n < 2; ++n)
#pragma unroll
                            for (int e = 0; e < 4; ++e) dst[(size_t)(32 * bj + 8 * fq + 4 * n + e) * LP] = f2bf(acc[ai][bj][m][n][e]);
                }
        } else {
            const int ch0 = 128 * (pn - 6) + 32 * wc + 8 * fq;
#pragma unroll
            for (int ai = 0; ai < 2; ++ai)
#pragma unroll
                for (int m = 0; m < 4; ++m) {
                    const int row = row0 + ai * HALF + m * 16, b = row >> 12, t = row & 4095;
                    f32x4 h0, h1;
#pragma unroll
                    for (int e = 0; e < 4; ++e) { h0[e] = acc[ai][0][m][0][e] * sigmoidf_(acc[ai][1][m][0][e]); h1[e] = acc[ai][0][m][1][e] * sigmoidf_(acc[ai][1][m][1][e]); }
                    u32x4 w; w.x = cvt_pk_bf16(h0[0], h0[1]); w.y = cvt_pk_bf16(h0[2], h0[3]); w.z = cvt_pk_bf16(h1[0], h1[1]); w.w = cvt_pk_bf16(h1[2], h1[3]);
                    *(u32x4*)(HCV + ((size_t)b * LP + 32 + t) * CW + ch0) = w;
                }
        }
    }
};
struct EpiRes {
    static constexpr bool PERM = false;
    const float* X; float* O;
    __device__ __forceinline__ void operator()(const f32x4 (&acc)[2][2][4][2], const Unit& u, int wr, int wc, int fr, int fq) const {
        const int row0 = u.pm * BM + wr * 64 + fr, col0 = u.pn * BM + wc * 32 + 4 * fq;
#pragma unroll
        for (int ai = 0; ai < 2; ++ai)
#pragma unroll
            for (int m = 0; m < 4; ++m) { const size_t off = (size_t)(row0 + ai * HALF + m * 16) * DM + col0;
#pragma unroll
                for (int bj = 0; bj < 2; ++bj)
#pragma unroll
                    for (int n = 0; n < 2; ++n) { const f32x4 xv = *(const f32x4*)(X + off + bj * HALF + n * 16); *(f32x4*)(O + off + bj * HALF + n * 16) = xv + acc[ai][bj][m][n]; } }
    }
};
struct EpiUp {
    static constexpr bool PERM = true;
    bf16* ACT; const float* bup;
    __device__ __forceinline__ void operator()(const f32x4 (&acc)[2][2][4][2], const Unit& u, int wr, int wc, int fr, int fq) const {
        const int c0 = 128 * u.pn + 32 * wc + 8 * fq;
        const float* bb = bup + (size_t)u.e * 2048 + c0;
        const f32x4 bg0 = *(const f32x4*)(bb), bg1 = *(const f32x4*)(bb + 4), bl0 = *(const f32x4*)(bb + 1024), bl1 = *(const f32x4*)(bb + 1028);
        const int row0 = u.pm * BM + wr * 64 + fr;
#pragma unroll
        for (int ai = 0; ai < 2; ++ai)
#pragma unroll
            for (int m = 0; m < 4; ++m) {
                const f32x4 g0 = acc[ai][0][m][0] + bg0, g1 = acc[ai][0][m][1] + bg1, l0 = acc[ai][1][m][0] + bl0, l1 = acc[ai][1][m][1] + bl1;
                f32x4 a0, a1;
#pragma unroll
                for (int e = 0; e < 4; ++e) {
                    const float ga = fminf(g0[e], SW_LIMIT), la = fminf(fmaxf(l0[e], -SW_LIMIT), SW_LIMIT); a0[e] = ga * sigmoidf_(SW_ALPHA * ga) * (la + 1.0f);
                    const float gb = fminf(g1[e], SW_LIMIT), lb = fminf(fmaxf(l1[e], -SW_LIMIT), SW_LIMIT); a1[e] = gb * sigmoidf_(SW_ALPHA * gb) * (lb + 1.0f); }
                u32x4 w; w.x = cvt_pk_bf16(a0[0], a0[1]); w.y = cvt_pk_bf16(a0[2], a0[3]); w.z = cvt_pk_bf16(a1[0], a1[1]); w.w = cvt_pk_bf16(a1[2], a1[3]);
                *(u32x4*)(ACT + (size_t)(row0 + ai * HALF + m * 16) * DE + c0) = w;
            }
    }
};
struct EpiDown {
    static constexpr bool PERM = true;
    bf16* Y; const float* bdn; const float* rgate;
    __device__ __forceinline__ void operator()(const f32x4 (&acc)[2][2][4][2], const Unit& u, int wr, int wc, int fr, int fq) const {
        const int c0 = u.pn * BM + wc * 32 + 8 * fq;
        const float* bb = bdn + (size_t)u.e * DM + c0;
        f32x4 bv[2][2];
#pragma unroll
        for (int bj = 0; bj < 2; ++bj)
#pragma unroll
            for (int n = 0; n < 2; ++n) bv[bj][n] = *(const f32x4*)(bb + bj * HALF + 4 * n);
        const int lrow0 = wr * 64 + fr;
        const float* gp = rgate + (size_t)u.e * CAP + u.rt * BM;
#pragma unroll
        for (int ai = 0; ai < 2; ++ai)
#pragma unroll
            for (int m = 0; m < 4; ++m) {
                const int lr = lrow0 + ai * HALF + m * 16; const float gt = gp[lr];
                bf16* rowp = Y + (size_t)(u.pm * BM + lr) * DM + c0;
#pragma unroll
                for (int bj = 0; bj < 2; ++bj) { const f32x4 v0 = (acc[ai][bj][m][0] + bv[bj][0]) * gt, v1 = (acc[ai][bj][m][1] + bv[bj][1]) * gt;
                    u32x4 w; w.x = cvt_pk_bf16(v0[0], v0[1]); w.y = cvt_pk_bf16(v0[2], v0[3]); w.z = cvt_pk_bf16(v1[0], v1[1]); w.w = cvt_pk_bf16(v1[2], v1[3]);
                    *(u32x4*)(rowp + bj * HALF) = w; }
            }
    }
};
}

struct Frame {
    LAS unsigned char* lds; LAS unsigned char* aux;
    gu32* ctl;
    int tid, lane, wave, vcu, G;
    const float *x, *meta, *g1, *w_in, *qg, *kg, *conv_w, *conv_b, *ln_g, *ln_b, *og, *w_out, *g2, *w_r, *b_r, *w_up, *b_up, *w_dn, *b_dn;
    float* out;
    bf16 *WinT, *WoT, *WdT, *WupT, *NM, *Q, *Kh, *VT, *HCV, *HN, *ACT, *Y;
    int* rtok; float* rgate; unsigned* tslot;
};

__device__ __forceinline__ int win_dest(int n0) {
    if (n0 < 1536) { const int tile = n0 >> 8, s = n0 & 255, wc = s >> 6, bj = (s >> 5) & 1; return tile * 256 + 128 * bj + 32 * wc; }
    if (n0 < 2048) { const int j = n0 - 1536; return 1536 + 256 * (j >> 7) + (j & 127); }
    const int j = n0 - 2048; return 1536 + 256 * (j >> 7) + 128 + (j & 127);
}
__device__ __forceinline__ int wup_dest(int n0) { if (n0 < 1024) return 256 * (n0 >> 7) + (n0 & 127); const int j = n0 - 1024; return 256 * (j >> 7) + 128 + (j & 127); }
__device__ __forceinline__ void tr_item(const float* W, int N, int k0, int n0, bf16* dst, const float* g, LAS float* scr, int lane) {
#pragma unroll 8
    for (int i = 0; i < 32; ++i) { const int kk = 2 * i + (lane >> 5); float v = W[(size_t)(k0 + kk) * N + n0 + (lane & 31)]; if (g) v *= g[k0 + kk]; scr[kk * 33 + (lane & 31)] = v; }
    LDS_WAIT(); asm volatile("" ::: "memory");
    const int c = lane & 7;
#pragma unroll
    for (int j = 0; j < 4; ++j) { const int n = (lane >> 3) + 8 * j; const LAS float* s = scr + (8 * c) * 33 + n;
        u32x4 o; o.x = cvt_pk_bf16(s[0 * 33], s[1 * 33]); o.y = cvt_pk_bf16(s[2 * 33], s[3 * 33]); o.z = cvt_pk_bf16(s[4 * 33], s[5 * 33]); o.w = cvt_pk_bf16(s[6 * 33], s[7 * 33]);
        *(u32x4*)(dst + (size_t)n * 1024 + k0 + 8 * c) = o; }
    LDS_WAIT(); asm volatile("" ::: "memory");
}
__device__ __forceinline__ void meta_unit(Frame& F, int mu) {
    LAS float* nmT = (LAS float*)F.lds;
    LAS float* part = (LAS float*)(F.lds + 65536);
    LAS float* rs = (LAS float*)(F.aux + A_RED);
    const int type = mu >> 3, hh = mu & 7, lane = F.lane, w = F.wave;
    for (int r = 2 * w; r < 2 * w + 2; ++r) { float s = 0.f; for (int k = lane; k < DM; k += 64) { const float v = F.meta[r * DM + k]; s += v * v; } s = wave_sum(s); if (lane == 0) rs[r] = __builtin_amdgcn_rsqf(s * (1.0f / DM) + EPS); }
    __syncthreads();
    for (int idx = F.tid; idx < NMETA * DM; idx += 512) { const int r = idx >> 10, k = idx & 1023; nmT[k * 16 + r] = F.meta[idx] * rs[r] * F.g1[k]; }
    __syncthreads();
    const int col = (type == 0 ? 512 : type == 1 ? 1024 : 1536) + 64 * hh + lane, colg = 2048 + 64 * hh + lane;
    float a1[16], a2[16];
#pragma unroll
    for (int r = 0; r < 16; ++r) { a1[r] = 0.f; a2[r] = 0.f; }
    for (int k = 128 * w; k < 128 * w + 128; ++k) {
        const float wv = F.w_in[(size_t)k * INC + col]; const float wg = (type == 2) ? F.w_in[(size_t)k * INC + colg] : 0.f;
        const LAS f32x4* np = (const LAS f32x4*)(nmT + k * 16);
#pragma unroll
        for (int q = 0; q < 4; ++q) { const f32x4 nv = np[q];
#pragma unroll
            for (int e = 0; e < 4; ++e) { a1[4 * q + e] += nv[e] * wv; a2[4 * q + e] += nv[e] * wg; } }
    }
#pragma unroll
    for (int r = 0; r < 16; ++r) { part[(w * 16 + r) * 64 + lane] = a1[r]; part[8192 + (w * 16 + r) * 64 + lane] = a2[r]; }
    __syncthreads();
    for (int r = 2 * w; r < 2 * w + 2; ++r) {
        float v = 0.f, v2 = 0.f;
#pragma unroll
        for (int ww = 0; ww < 8; ++ww) { v += part[(ww * 16 + r) * 64 + lane]; v2 += part[8192 + (ww * 16 + r) * 64 + lane]; }
        if (type == 0) { const float ss = wave_sum(v * v); const bf16 o = f2bf(v * __builtin_amdgcn_rsqf(ss * (1.0f / 64.0f) + EPS) * F.kg[lane]);
            for (int b = 0; b < NB; ++b) F.Kh[((size_t)(b * NH + hh) * LP + LPAD + r) * HD + lane] = o; }
        else if (type == 1) { const bf16 o = f2bf(v); for (int b = 0; b < NB; ++b) F.VT[((size_t)(b * NH + hh) * HD + lane) * LP + LPAD + r] = o; }
        else { const bf16 o = f2bf(v * sigmoidf_(v2)); for (int b = 0; b < NB; ++b) F.HCV[((size_t)b * LP + LPAD + r) * CW + 64 * hh + lane] = o; }
    }
    __syncthreads();
}
__device__ __forceinline__ void p0_prologue(Frame& F) {
    if (F.vcu < 24) meta_unit(F, F.vcu);
    for (int mu = F.vcu + F.G; mu < 24; mu += F.G) meta_unit(F, mu);
    LAS float* scr = (LAS float*)(F.lds + F.wave * 16384);
    const int gw = F.vcu * NWAVES + F.wave, NGW = F.G * NWAVES, lane = F.lane;
    for (int it = gw; it < 192; it += NGW) {
        const u32x4 z = (u32x4){0u, 0u, 0u, 0u};
        if (it < 64) { u32x4* p = (u32x4*)(F.Kh + (size_t)it * LP * HD); p[lane] = z; p[64 + lane] = z; }
        else if (it < 128) { u32x4* p = (u32x4*)(F.VT + ((size_t)(it - 64) * HD + lane) * LP); p[0] = z; p[1] = z; }
        else { const int j = it - 128, b = j >> 3, rr = (j & 7) * 2; u32x4* p = (u32x4*)(F.HCV + ((size_t)b * LP + rr) * CW); p[lane] = z; p[64 + lane] = z; }
    }
    constexpr int I_IN = 16 * 80, I_O = 16 * 32, I_UP = NE * 16 * 64, I_DN = NE * 16 * 32, NITEMS = I_IN + I_O + I_UP + I_DN;
    for (int it = gw; it < NITEMS; it += NGW) {
        int r = it;
        if (r < I_IN) { const int kb = r / 80, nb = r % 80; tr_item(F.w_in, INC, 64 * kb, 32 * nb, F.WinT + (size_t)win_dest(32 * nb) * 1024, F.g1, scr, lane); continue; } r -= I_IN;
        if (r < I_O) { const int kb = r / 32, nb = r % 32; tr_item(F.w_out, DM, 64 * kb, 32 * nb, F.WoT + (size_t)(32 * nb) * 1024, nullptr, scr, lane); continue; } r -= I_O;
        if (r < I_UP) { const int e = r >> 10, rr = r & 1023, kb = rr >> 6, nb = rr & 63;
            tr_item(F.w_up + (size_t)e * DM * 2048, 2048, 64 * kb, 32 * nb, F.WupT + ((size_t)e * 2048 + wup_dest(32 * nb)) * 1024, F.g2, scr, lane); continue; } r -= I_UP;
        { const int e = r >> 9, rr = r & 511, kb = rr >> 5, nb = rr & 31;
            tr_item(F.w_dn + (size_t)e * DE * DM, DM, 64 * kb, 32 * nb, F.WdT + ((size_t)e * DM + 32 * nb) * 1024, nullptr, scr, lane); }
    }
    for (int m = gw; m < NTOK; m += NGW) {
        const f32x4* xr = (const f32x4*)(F.x + (size_t)m * DM) + lane;
        f32x4 v[4]; float s = 0.f;
#pragma unroll
        for (int j = 0; j < 4; ++j) { v[j] = xr[64 * j]; s += (v[j].x * v[j].x + v[j].y * v[j].y) + (v[j].z * v[j].z + v[j].w * v[j].w); }
        const float rstd = __builtin_amdgcn_rsqf(wave_sum(s) * (1.0f / DM) + EPS);
        u32x2* o8 = (u32x2*)(F.NM + (size_t)m * DM) + lane;
#pragma unroll
        for (int j = 0; j < 4; ++j) { u32x2 o; o.x = cvt_pk_bf16(v[j].x * rstd, v[j].y * rstd); o.y = cvt_pk_bf16(v[j].z * rstd, v[j].w * rstd); o8[64 * j] = o; }
    }
}

__device__ __forceinline__ float wave_reduce32(float (&v)[32], int lane) {
#pragma unroll
    for (int s = 0; s < 5; ++s) { const int m = 32 >> s, n = 16 >> s; const bool up = (lane & m) != 0;
#pragma unroll
        for (int i = 0; i < n; ++i) { const float send = up ? v[i] : v[i + n], keep = up ? v[i + n] : v[i]; v[i] = keep + __shfl_xor(send, m); } }
    return v[0] + __shfl_xor(v[0], 1);
}
__device__ __forceinline__ void conv_phase(Frame& F) {
    const int c = F.tid, lane = F.lane;
    LAS float* red = (LAS float*)(F.aux + A_RED); LAS float* tot = (LAS float*)(F.aux + A_TOT);
    float w[CKW];
#pragma unroll
    for (int j = 0; j < CKW; ++j) w[j] = F.conv_w[j * CW + c];
    const float cb = F.conv_b[c], lg = F.ln_g[c], lb = F.ln_b[c];
    for (int u = F.vcu; u < NTOK / 16; u += F.G) {
        const int t0 = u * 16, b = t0 >> 12, tb = t0 & 4095;
        const bf16* hp = F.HCV + ((size_t)b * LP + tb + 2) * CW + c;
        float h[46];
#pragma unroll
        for (int i = 0; i < 46; ++i) h[i] = bf2f(hp[(size_t)i * CW]);
        float v[16], rr[32];
#pragma unroll
        for (int j = 0; j < 16; ++j) { float s = cb;
#pragma unroll
            for (int k = 0; k < CKW; ++k) s += w[k] * h[j + k];
            v[j] = s; rr[j] = s; rr[16 + j] = s * s; }
        const float rsum = wave_reduce32(rr, lane);
        if ((lane & 1) == 0) red[F.wave * 32 + (lane >> 1)] = rsum;
        __syncthreads();
        if (F.tid < 32) { float s = 0.f;
#pragma unroll
            for (int ww = 0; ww < 8; ++ww) s += red[ww * 32 + F.tid]; tot[F.tid] = s; }
        __syncthreads();
#pragma unroll
        for (int j = 0; j < 16; ++j) { const float mean = tot[j] * (1.0f / CW), var = fmaxf(tot[16 + j] * (1.0f / CW) - mean * mean, 0.f);
            const float y = (v[j] - mean) * __builtin_amdgcn_rsqf(var + EPS) * lg + lb;
            F.NM[(size_t)(t0 + j) * DM + SBW + c] = f2bf(y * sigmoidf_(y)); }
    }
}

template <bool EARLY>
__device__ __forceinline__ void attn_wave_unit(Frame& F, int bh, int qb, LAS float* stg) {
    const int lane = F.lane, r = lane & 31, hf = lane >> 5;
    const bf16* qp = F.Q + ((size_t)bh * SEQ + qb * 32 + r) * HD + 8 * hf;
    bf16x8 qf[4];
#pragma unroll
    for (int s = 0; s < 4; ++s) qf[s] = *(const bf16x8*)(qp + 16 * s);
    const int krow = (r & ~12) | ((r & 4) << 1) | ((r & 8) >> 1);
    const bf16* kp = F.Kh + ((size_t)bh * LP + krow) * HD + 8 * hf;
    const bf16* vp = F.VT + ((size_t)bh * HD + r) * LP + 8 * hf;
    f32x16 o0, o1;
#pragma unroll
    for (int i = 0; i < 16; ++i) { o0[i] = 0.f; o1[i] = 0.f; }
    float C = 1.0f;
    int jb = qb + 1;
    bf16x8 kf[4], vf[4], kn[4], vn[4];
#define LOADKV(KF, VF, J) do { _Pragma("unroll") for (int s = 0; s < 4; ++s) KF[s] = *(const bf16x8*)(kp + (size_t)(J) * 32 * HD + 16 * s); \
        _Pragma("unroll") for (int d = 0; d < 2; ++d) _Pragma("unroll") for (int s = 0; s < 2; ++s) VF[d * 2 + s] = *(const bf16x8*)(vp + (size_t)d * 32 * LP + (J) * 32 + 16 * s); } while (0)
    LOADKV(kf, vf, jb);
    for (;;) {
        const int jn = jb > 0 ? jb - 1 : 0;
        LOADKV(kn, vn, jn);
        f32x16 st;
#pragma unroll
        for (int i = 0; i < 16; ++i) st[i] = 0.f;
#pragma unroll
        for (int s = 0; s < 4; ++s) st = __builtin_amdgcn_mfma_f32_32x32x16_bf16(kf[s], qf[s], st, 0, 0, 0);
        const bool diag = (jb == qb + 1), first = (jb == 0);
        float be[16], ke[16];
#pragma unroll
        for (int i = 0; i < 16; ++i) {
            const int c = 16 * (i >> 3) + 8 * hf + (i & 7);
            const float u = fast_exp2(-st[i]);
            const float bt = fast_rcp(1.0f + u);
            const bool valid = diag ? (c < r) : (first ? (c >= 16) : true);
            be[i] = valid ? bt : 0.f; ke[i] = valid ? u * bt : 1.0f;
        }
        float plo = ke[0], phi = ke[8];
#pragma unroll
        for (int i = 1; i < 8; ++i) { plo *= ke[i]; phi *= ke[8 + i]; }
        const float plo_o = __shfl_xor(plo, 32), phi_o = __shfl_xor(phi, 32);
        const float X1 = phi * phi_o, X0 = plo * plo_o, CX1 = C * X1;
        float run = hf ? C : C * phi_o;
        float a[16];
#pragma unroll
        for (int i = 15; i >= 8; --i) { a[i] = be[i] * run; run *= ke[i]; }
        run = hf ? CX1 : CX1 * plo_o;
#pragma unroll
        for (int i = 7; i >= 0; --i) { a[i] = be[i] * run; run *= ke[i]; }
        C = CX1 * X0;
        u32x4 p0, p1;
        p0.x = cvt_pk_bf16(a[0], a[1]); p0.y = cvt_pk_bf16(a[2], a[3]); p0.z = cvt_pk_bf16(a[4], a[5]); p0.w = cvt_pk_bf16(a[6], a[7]);
        p1.x = cvt_pk_bf16(a[8], a[9]); p1.y = cvt_pk_bf16(a[10], a[11]); p1.z = cvt_pk_bf16(a[12], a[13]); p1.w = cvt_pk_bf16(a[14], a[15]);
        const bf16x8 af0 = __builtin_bit_cast(bf16x8, p0), af1 = __builtin_bit_cast(bf16x8, p1);
        o0 = __builtin_amdgcn_mfma_f32_32x32x16_bf16(af0, vf[0], o0, 0, 0, 0); o0 = __builtin_amdgcn_mfma_f32_32x32x16_bf16(af1, vf[1], o0, 0, 0, 0);
        o1 = __builtin_amdgcn_mfma_f32_32x32x16_bf16(af0, vf[2], o1, 0, 0, 0); o1 = __builtin_amdgcn_mfma_f32_32x32x16_bf16(af1, vf[3], o1, 0, 0, 0);
        if (jb == 0) break;
        if (EARLY) { if (__all(C < ATTN_CUT)) break; }
        --jb;
#pragma unroll
        for (int s = 0; s < 4; ++s) { kf[s] = kn[s]; vf[s] = vn[s]; }
    }
#undef LOADKV
#pragma unroll
    for (int i = 0; i < 16; ++i) { const int q = (i & 3) + 8 * (i >> 2) + 4 * hf; stg[q * 68 + r] = o0[i]; stg[q * 68 + 32 + r] = o1[i]; }
    LDS_WAIT(); asm volatile("" ::: "memory");
    const int q = lane >> 1, half = lane & 1, h = bh & 7, b = bh >> 3;
    f32x4 v[8]; float ss = 0.f;
#pragma unroll
    for (int j = 0; j < 8; ++j) { v[j] = *(const LAS f32x4*)(stg + q * 68 + 32 * half + 4 * j); ss += (v[j].x * v[j].x + v[j].y * v[j].y) + (v[j].z * v[j].z + v[j].w * v[j].w); }
    ss += __shfl_xor(ss, 1);
    const float rstd = __builtin_amdgcn_rsqf(ss * (1.0f / 64.0f) + EPS);
    const float* gp = F.og + h * HD + 32 * half;
    bf16* dst = F.NM + ((size_t)(b * SEQ + qb * 32 + q)) * DM + h * HD + 32 * half;
#pragma unroll
    for (int j = 0; j < 4; ++j) { const f32x4 g0 = *(const f32x4*)(gp + 8 * j), g1 = *(const f32x4*)(gp + 8 * j + 4); const f32x4 a0 = v[2 * j] * rstd * g0, a1 = v[2 * j + 1] * rstd * g1;
        u32x4 w; w.x = cvt_pk_bf16(a0[0], a0[1]); w.y = cvt_pk_bf16(a0[2], a0[3]); w.z = cvt_pk_bf16(a1[0], a1[1]); w.w = cvt_pk_bf16(a1[2], a1[3]);
        *(u32x4*)(dst + 8 * j) = w; }
    LDS_WAIT(); asm volatile("" ::: "memory");
}
__device__ __forceinline__ void attn_phase(Frame& F) {
    LAS float* stg = (LAS float*)(F.lds + F.wave * 8704);
    for (int wu = F.vcu; wu < 64 * 16; wu += F.G) {
        const int bh = wu & 63, j = wu >> 6;
        const int i = j >> 2, j0 = j & 3;
        const int grp = (i == 0) ? j0 : (i == 1) ? 15 - j0 : (i == 2) ? 4 + j0 : 11 - j0;
        attn_wave_unit<ATTN_EARLY != 0>(F, bh, grp * 8 + F.wave, stg);
    }
}

__device__ __forceinline__ void router_phase(Frame& F) {
    LAS float* Wt = (LAS float*)F.lds;
    LAS int* hist = (LAS int*)(F.aux + A_HIST); LAS int* base = (LAS int*)(F.aux + A_BASE);
    LAS int* sel_e = (LAS int*)(F.aux + A_SELE); LAS float* sel_g = (LAS float*)(F.aux + A_SELG); LAS int* rank = (LAS int*)(F.aux + A_RANK);
    const int lane = F.lane;
    for (int idx = F.tid; idx < NE * DM; idx += 512) { const int e = idx >> 10, k = idx & 1023; Wt[idx] = F.w_r[k * NE + e] * F.g2[k]; }
    __syncthreads();
    for (int blk = F.vcu; blk < NTOK / 128; blk += F.G) {
        if (F.tid < 32) hist[F.tid] = 0;
        for (int tl = F.wave * 16; tl < F.wave * 16 + 16; ++tl) {
            const int t = blk * 128 + tl;
            const f32x4* xr = (const f32x4*)(F.out + (size_t)t * DM) + lane;
            f32x4 xv[4]; float s = 0.f;
#pragma unroll
            for (int j = 0; j < 4; ++j) { xv[j] = xr[64 * j]; s += (xv[j].x * xv[j].x + xv[j].y * xv[j].y) + (xv[j].z * xv[j].z + xv[j].w * xv[j].w); }
            const float rstd = __builtin_amdgcn_rsqf(wave_sum(s) * (1.0f / DM) + EPS);
            u32x2* o8 = (u32x2*)(F.HN + (size_t)t * DM) + lane;
#pragma unroll
            for (int j = 0; j < 4; ++j) { u32x2 o; o.x = cvt_pk_bf16(xv[j].x * rstd, xv[j].y * rstd); o.y = cvt_pk_bf16(xv[j].z * rstd, xv[j].w * rstd); o8[64 * j] = o; }
            float acc[32];
#pragma unroll
            for (int e = 0; e < 32; ++e) { float a = 0.f;
#pragma unroll
                for (int j = 0; j < 4; ++j) { const f32x4 wv = *(const LAS f32x4*)(Wt + e * 1024 + 256 * j + 4 * lane); a += (xv[j].x * wv.x + xv[j].y * wv.y) + (xv[j].z * wv.z + xv[j].w * wv.w); }
                acc[e] = a; }
            const int e_me = lane >> 1;
            float val = wave_reduce32(acc, lane) * rstd + F.b_r[e_me];
            int se[4]; float sv[4];
#pragma unroll
            for (int k = 0; k < 4; ++k) {
                float bv = val; int bi = e_me;
#pragma unroll
                for (int m = 2; m < 64; m <<= 1) { const float ov = __shfl_xor(bv, m); const int oi = __shfl_xor(bi, m); if (ov > bv || (ov == bv && oi < bi)) { bv = ov; bi = oi; } }
                se[k] = bi; sv[k] = bv; if (e_me == bi) val = -INFINITY;
            }
            const float e1 = __expf(sv[1] - sv[0]), e2 = __expf(sv[2] - sv[0]), e3 = __expf(sv[3] - sv[0]); const float inv = 1.0f / (1.0f + e1 + e2 + e3);
            if (lane == 0) { sel_e[tl * 4 + 0] = se[0]; sel_e[tl * 4 + 1] = se[1]; sel_e[tl * 4 + 2] = se[2]; sel_e[tl * 4 + 3] = se[3];
                sel_g[tl * 4 + 0] = inv; sel_g[tl * 4 + 1] = e1 * inv; sel_g[tl * 4 + 2] = e2 * inv; sel_g[tl * 4 + 3] = e3 * inv; }
        }
        __syncthreads();
        const int a = F.tid, ea = sel_e[a];
        rank[a] = __hip_atomic_fetch_add(hist + ea, 1, __ATOMIC_RELAXED, __HIP_MEMORY_SCOPE_WORKGROUP);
        __syncthreads();
        if (F.tid < 32) base[F.tid] = (int)__hip_atomic_fetch_add((unsigned*)(F.ctl + CW_CNT + 64 * F.tid), (unsigned)hist[F.tid], RLX_AGENT);
        __syncthreads();
        { const int pos = base[ea] + rank[a], t = blk * 128 + (a >> 2);
          F.rtok[(size_t)ea * CAP + pos] = t; F.rgate[(size_t)ea * CAP + pos] = sel_g[a]; F.tslot[(size_t)t * 4 + (a & 3)] = ((unsigned)ea << 16) | (unsigned)pos; }
        __syncthreads();
    }
}

__device__ __forceinline__ void moe_setup(Frame& F) {
    LAS int* tpre = (LAS int*)(F.aux + A_TPRE); LAS int* cnt = (LAS int*)(F.aux + A_CNT);
    if (F.tid < 32) cnt[F.tid] = (int)__hip_atomic_load((unsigned*)(F.ctl + CW_CNT + 64 * F.tid), RLX_AGENT);
    __syncthreads();
    if (F.tid == 0) { int s = 0; for (int e = 0; e < NE; ++e) { tpre[e] = s; s += (cnt[e] + 255) >> 8; } tpre[NE] = s; }
    __syncthreads();
}

__device__ __forceinline__ void combine_phase(Frame& F) {
    const LAS int* tpre = (const LAS int*)(F.aux + A_TPRE);
    const int gw = F.vcu * NWAVES + F.wave, NGW = F.G * NWAVES, lane = F.lane;
    for (int t = gw; t < NTOK; t += NGW) {
        f32x4* orow = (f32x4*)(F.out + (size_t)t * DM) + lane;
        f32x4 v[4];
#pragma unroll
        for (int j = 0; j < 4; ++j) v[j] = orow[64 * j];
#pragma unroll
        for (int k = 0; k < 4; ++k) {
            const unsigned s = F.tslot[(size_t)t * 4 + k]; const int e = (int)(s >> 16), pos = (int)(s & 0xffffu);
            const size_t row = (size_t)tpre[e] * 256 + pos;
            const u32x2* yr = (const u32x2*)(F.Y + row * DM) + lane;
#pragma unroll
            for (int j = 0; j < 4; ++j) { const u32x2 w = yr[64 * j];
                v[j].x += __uint_as_float(w.x << 16); v[j].y += __uint_as_float(w.x & 0xffff0000u); v[j].z += __uint_as_float(w.y << 16); v[j].w += __uint_as_float(w.y & 0xffff0000u); }
        }
#pragma unroll
        for (int j = 0; j < 4; ++j) orow[64 * j] = v[j];
    }
}

struct Args { const float* in[19]; float* out; unsigned char* ws; int ph_lo, ph_hi; };
template <int PLO, int PHI> __global__ void __launch_bounds__(NWAVES * 64, 2) hymba_fwd(Args args) {
    extern __shared__ __attribute__((aligned(16))) unsigned char lds[];
    Frame F;
    F.lds = (LAS unsigned char*)lds; F.aux = F.lds + AUX_OFF;
    F.tid = threadIdx.x; F.lane = F.tid & 63; F.wave = __builtin_amdgcn_readfirstlane(F.tid >> 6);
    F.G = gridDim.x; { const int bx = blockIdx.x; F.vcu = (F.G % 8 == 0) ? (bx % 8) * (F.G / 8) + bx / 8 : bx; }
    unsigned char* ws = args.ws;
    F.ctl = (gu32*)(ws + WS_CTL);
    F.x = args.in[0]; F.meta = args.in[1]; F.g1 = args.in[2]; F.w_in = args.in[3]; F.qg = args.in[4]; F.kg = args.in[5]; F.conv_w = args.in[6]; F.conv_b = args.in[7];
    F.ln_g = args.in[8]; F.ln_b = args.in[9]; F.og = args.in[10]; F.w_out = args.in[11]; F.g2 = args.in[12]; F.w_r = args.in[13]; F.b_r = args.in[14];
    F.w_up = args.in[15]; F.b_up = args.in[16]; F.w_dn = args.in[17]; F.b_dn = args.in[18]; F.out = args.out;
    F.WinT = (bf16*)(ws + WS_WIN); F.WoT = (bf16*)(ws + WS_WO); F.WdT = (bf16*)(ws + WS_WD); F.WupT = (bf16*)(ws + WS_WUP); F.NM = (bf16*)(ws + WS_NM);
    F.Q = (bf16*)(ws + WS_Q); F.Kh = (bf16*)(ws + WS_K); F.VT = (bf16*)(ws + WS_VT); F.HCV = (bf16*)(ws + WS_HCV); F.HN = (bf16*)(ws + WS_HN); F.ACT = (bf16*)(ws + WS_ACT); F.Y = (bf16*)(ws + WS_Y);
    F.rtok = (int*)(ws + WS_RTOK); F.rgate = (float*)(ws + WS_RGATE); F.tslot = (unsigned*)(ws + WS_TSLOT);
    for (int u = F.tid; u < 512 / 4; u += NWAVES * 64) ((LAS unsigned*)(F.lds + LDSCTL_OFF))[u] = 0u;
    __syncthreads();
    XcdBarrier bar; bar.bar = (unsigned*)(F.ctl + CW_BAR); bar.x = 0; bar.st = nullptr;
    if (PHI - PLO > 1) bar = xcd_barrier_post((unsigned*)(F.ctl + CW_BAR), (volatile LAS unsigned*)(F.lds + MISC_OFF) + 8);
    constexpr int lo = PLO, hi = PHI;
#ifndef PH_MASK
#define PH_MASK 0xff
#endif
#define IN(k) (((PH_MASK >> (k)) & 1) && lo <= (k) && (k) < hi)
#define SEAM(k) do { if (IN(k) && IN((k) + 1)) xcd_barrier(bar); } while (0)
    bool moe_ready = false;
#define FRESH() do { int t_ = threadIdx.x; asm volatile("" : "+v"(t_)); F.tid = t_; F.lane = t_ & 63; F.wave = __builtin_amdgcn_readfirstlane(t_ >> 6); } while (0)

    if (IN(0)) { FRESH(); p0_prologue(F); SEAM(0); }
    if (IN(1)) { FRESH();
        pg8::StaticSched S; S.init(NTOK, INC, DM, F.WinT, F.G, (int)blockIdx.x);
        pg8::EpiIn E{F.Q, F.Kh, F.VT, F.HCV, F.qg, F.kg};
        pg8::gemm_phase(F.lds, (const char*)F.NM, DM, S, E, F.tid);
        SEAM(1);
    }
    if (IN(2)) { FRESH(); conv_phase(F); attn_phase(F); SEAM(2); }
    if (IN(3)) { FRESH();
        pg8::StaticSched S; S.init(NTOK, DM, DM, F.WoT, F.G, (int)blockIdx.x);
        pg8::EpiRes E{F.x, F.out};
        pg8::gemm_phase(F.lds, (const char*)F.NM, DM, S, E, F.tid);
        SEAM(3);
    }
    if (IN(4)) { FRESH(); router_phase(F); SEAM(4); }
    if (IN(5)) { FRESH();
        if (!moe_ready) { moe_setup(F); moe_ready = true; }
        const LAS int* tpre = (const LAS int*)(F.aux + A_TPRE); const LAS int* cnt = (const LAS int*)(F.aux + A_CNT);
        LAS unsigned* idx = (LAS unsigned*)(F.aux + A_IDX);
        pg8::MoeSched<true> S; S.G = F.G; S.v = F.vcu; S.NT = 8; S.ntot = tpre[NE]; S.K2 = 2048u; S.Bt = (const char*)F.WupT; S.bstride = (size_t)2048 * 1024 * 2; S.tpre = tpre; S.idx = idx;
        { pg8::Unit u; for (int i = 0; i < MAXU && S.next(i, u); ++i) { if (F.tid < 256) { const int lr = u.rt * 256 + F.tid; const int tk = (lr < cnt[u.e]) ? F.rtok[(size_t)u.e * CAP + lr] : 0; idx[i * 256 + F.tid] = (unsigned)tk * 2048u; } } }
        __syncthreads();
        pg8::EpiUp E{F.ACT, F.b_up};
        pg8::gemm_phase(F.lds, (const char*)F.HN, DM, S, E, F.tid);
        SEAM(5);
    }
    if (IN(6)) { FRESH();
        if (!moe_ready) { moe_setup(F); moe_ready = true; }
        const LAS int* tpre = (const LAS int*)(F.aux + A_TPRE);
        pg8::MoeSched<false> S; S.G = F.G; S.v = F.vcu; S.NT = 4; S.ntot = tpre[NE]; S.K2 = 2048u; S.Bt = (const char*)F.WdT; S.bstride = (size_t)1024 * 1024 * 2; S.tpre = tpre; S.idx = nullptr;
        pg8::EpiDown E{F.Y, F.b_dn, F.rgate};
        pg8::gemm_phase(F.lds, (const char*)F.ACT, DE, S, E, F.tid);
        SEAM(6);
    }
    if (IN(7)) { FRESH();
        if (!moe_ready) { moe_setup(F); moe_ready = true; }
        combine_phase(F);
    }
#undef IN
#undef SEAM
}

template <int PLO, int PHI> static bool launch_range(int& grid, const Args& a, hipStream_t stream) {
    static bool ready = false;
    if (!ready) {
        int dev = 0, cus = 0, per_cu = 0;
        if (hipGetDevice(&dev) != hipSuccess || hipDeviceGetAttribute(&cus, hipDeviceAttributeMultiprocessorCount, dev) != hipSuccess) return false;
        if (hipFuncSetAttribute((const void*)hymba_fwd<PLO, PHI>, hipFuncAttributeMaxDynamicSharedMemorySize, LDS_BYTES) != hipSuccess) { fprintf(stderr, "kernel_launch: hipFuncSetAttribute failed\n"); return false; }
        if (hipOccupancyMaxActiveBlocksPerMultiprocessor(&per_cu, (const void*)hymba_fwd<PLO, PHI>, NWAVES * 64, LDS_BYTES) != hipSuccess || per_cu < 1) fprintf(stderr, "kernel_launch: occupancy query says %d\n", per_cu);
        (void)hipGetLastError();
        grid = cus;
        ready = true;
    }
    hipLaunchKernelGGL((hymba_fwd<PLO, PHI>), dim3(grid), dim3(NWAVES * 64), LDS_BYTES, stream, a);
    return true;
}
extern "C" void kernel_launch(void* const* d_in, const int* in_sizes, int n_in, void* d_out, int out_size, void* d_ws, size_t ws_size, hipStream_t stream) {
    static int grid = 0;
    if (grid < 0) return;
    if (n_in != 19 || in_sizes[0] != NTOK * DM || out_size != NTOK * DM || ws_size < WS_END) { fprintf(stderr, "kernel_launch: unexpected shapes (n_in %d, ws %zu); nothing launched\n", n_in, ws_size); grid = -1; return; }
    if (hipMemsetAsync((char*)d_ws + WS_CTL, 0, CTL_ZERO_BYTES, stream) != hipSuccess) return;
    Args a{};
    for (int i = 0; i < 19; ++i) a.in[i] = (const float*)d_in[i];
    a.out = (float*)d_out; a.ws = (unsigned char*)d_ws; a.ph_lo = 0; a.ph_hi = 8;
#if MK_N_LAUNCHES == 1
    if (!launch_range<0, 8>(grid, a, stream)) grid = -1;
#else
    bool ok = launch_range<0, 1>(grid, a, stream) && launch_range<1, 2>(grid, a, stream) && launch_range<2, 3>(grid, a, stream) && launch_range<3, 4>(grid, a, stream)
           && launch_range<4, 5>(grid, a, stream) && launch_range<5, 6>(grid, a, stream) && launch_range<6, 7>(grid, a, stream) && launch_range<7, 8>(grid, a, stream);
    if (!ok) grid = -1;
#endif
}
```

```cpp
#include <hip/hip_runtime.h>
#include <cstdio>
#include <cstdint>

#ifndef MK_N_LAUNCHES
#define MK_N_LAUNCHES 1
#endif
#ifndef PROBE_REP
#define PROBE_REP 0
#endif
#ifndef PROBE_P7
#define PROBE_P7 0
#endif
#define NREP(k) ((((unsigned)PROBE_REP >> (4 * (k))) & 15u) + 1u)
#ifndef ATTN_EARLY
#define ATTN_EARLY 1
#endif

#define LAS __attribute__((address_space(3)))
#define GAS __attribute__((address_space(1)))
typedef unsigned short bf16;
typedef short bf16x8 __attribute__((ext_vector_type(8)));
typedef float f32x2 __attribute__((ext_vector_type(2)));
typedef float f32x4 __attribute__((ext_vector_type(4)));
typedef float f32x16 __attribute__((ext_vector_type(16)));
typedef unsigned u32x2 __attribute__((ext_vector_type(2)));
typedef unsigned u32x4 __attribute__((ext_vector_type(4)));
typedef GAS unsigned gu32;

constexpr int NB = 8, SEQ = 4096, DM = 1024, NTOK = NB * SEQ;
constexpr int NMETA = 16, LPAD = 16, LP = LPAD + NMETA + SEQ;
constexpr int NH = 8, HD = 64, SBW = 512, CW = 512, CKW = 31, INC = 2560;
constexpr int NE = 32, TOPK = 4, DE = 1024, CAP = NTOK;
constexpr int MAXROWS = NTOK * TOPK + NE * 256;
constexpr float EPS = 1e-6f;
constexpr float LOG2E = 1.4426950408889634f;
constexpr float QSCALE = 0.125f * LOG2E;
constexpr float SW_LIMIT = 7.0f, SW_ALPHA = 1.702f;
constexpr float ATTN_CUT = 1e-30f;

constexpr size_t MiB = 1u << 20;
constexpr size_t WS_CTL = 0, CTL_ZERO_BYTES = 1 * MiB;
constexpr size_t WS_WIN = 1 * MiB, WS_WO = 6 * MiB, WS_WD = 8 * MiB, WS_WUP = 72 * MiB;
constexpr size_t WS_NM = 200 * MiB;
constexpr size_t WS_Q = 264 * MiB, WS_K = 296 * MiB, WS_VT = 329 * MiB, WS_HCV = 362 * MiB;
constexpr size_t WS_ACT = 395 * MiB;
constexpr size_t WS_RTOK = 667 * MiB, WS_RGATE = 671 * MiB, WS_TSLOT = 675 * MiB, WS_END = 676 * MiB;
constexpr size_t WS_HN = WS_Q;
constexpr size_t WS_Y = WS_WUP;
static_assert(WS_Y + (size_t)MAXROWS * 2048 <= WS_HCV && WS_ACT + (size_t)MAXROWS * 2048 <= WS_RTOK, "ws map");
constexpr int CW_TMO = 0, CW_BAR = 4096, CW_CNT = 8192;

constexpr int RING_BYTES = 131072;
constexpr int LDSCTL_OFF = RING_BYTES, MISC_OFF = LDSCTL_OFF + 320, AUX_OFF = LDSCTL_OFF + 512;
constexpr int A_TPRE = 0, A_CNT = 256, A_HIST = 384, A_BASE = 512, A_RED = 640, A_TOT = 1664, A_SELE = 1792, A_SELG = 3840, A_RANK = 5888, A_IDX = 8192;
constexpr int MAXU = 17;
constexpr int LDS_BYTES = AUX_OFF + A_IDX + MAXU * 1024;
static_assert(LDS_BYTES <= 163840, "LDS");
constexpr int NWAVES = 8;

#define LDS_WAIT() asm volatile("s_waitcnt lgkmcnt(0)" ::: "memory")
#define VM_WAIT() asm volatile("s_waitcnt vmcnt(0)" ::: "memory")
#define RLX_AGENT __ATOMIC_RELAXED, __HIP_MEMORY_SCOPE_AGENT

__device__ __forceinline__ unsigned cvt_pk_bf16(float lo, float hi) { unsigned r; asm volatile("v_cvt_pk_bf16_f32 %0, %1, %2" : "=v"(r) : "v"(lo), "v"(hi)); return r; }
__device__ __forceinline__ float bf2f(bf16 b) { return __uint_as_float(((unsigned)b) << 16); }
__device__ __forceinline__ bf16 f2bf(float f) { return (bf16)(cvt_pk_bf16(f, 0.f) & 0xffffu); }
__device__ __forceinline__ float fast_rcp(float x) { return __builtin_amdgcn_rcpf(x); }
__device__ __forceinline__ float fast_exp2(float x) { return __builtin_amdgcn_exp2f(x); }
__device__ __forceinline__ float sigmoidf_(float x) { return fast_rcp(1.0f + fast_exp2(-x * LOG2E)); }
template <int CTRL> __device__ __forceinline__ float dpp_f(float v) { return __builtin_bit_cast(float, __builtin_amdgcn_update_dpp(0, __builtin_bit_cast(int, v), CTRL, 0xf, 0xf, true)); }
template <int CTRL> __device__ __forceinline__ int dpp_i(int v) { return __builtin_amdgcn_update_dpp(0, v, CTRL, 0xf, 0xf, true); }
#define DPP_ROW_MIRROR 0x140
#define DPP_ROW_HALF_MIRROR 0x141
#define DPP_QUAD_REV 0x1B
#define DPP_QUAD_SWAP 0xB1
__device__ __forceinline__ float row_allsum(float v) {
    v += dpp_f<DPP_ROW_MIRROR>(v); v += dpp_f<DPP_ROW_HALF_MIRROR>(v); v += dpp_f<DPP_QUAD_REV>(v); v += dpp_f<DPP_QUAD_SWAP>(v); return v;
}
__device__ __forceinline__ float swap16_sum(float a, float b) {
    const auto r = __builtin_amdgcn_permlane16_swap(__float_as_uint(a), __float_as_uint(b), false, false); return __uint_as_float(r[0]) + __uint_as_float(r[1]);
}
__device__ __forceinline__ float swap32_sum(float a, float b) {
    const auto r = __builtin_amdgcn_permlane32_swap(__float_as_uint(a), __float_as_uint(b), false, false); return __uint_as_float(r[0]) + __uint_as_float(r[1]);
}
__device__ __forceinline__ float wave_sum(float v) { v = row_allsum(v); v = swap16_sum(v, v); return swap32_sum(v, v); }
__device__ __forceinline__ void wave_reduce32(float (&v)[32]) {
#pragma unroll
    for (int i = 0; i < 16; ++i) v[i] = swap32_sum(v[i], v[i + 16]);
#pragma unroll
    for (int i = 0; i < 8; ++i) v[i] = swap16_sum(v[i], v[i + 8]);
#pragma unroll
    for (int i = 0; i < 8; ++i) v[i] = row_allsum(v[i]);
}
#define XB_TMO      128
#define XB_XCNT(j)  (256  + 64 * (j))
#define XB_XSUB(j)  (1280 + 64 * (j))
#define XB_XGEN(j)  (2304 + 64 * (j))
#define XB_TOP      3328
#define XB_TOPGEN   3392
#define XCD_BAR_WORDS 3456
#define XB_SPIN_CAP (1u << 18)
__device__ __forceinline__ unsigned xb_ld(unsigned* p)              { return __hip_atomic_load(p, __ATOMIC_RELAXED, __HIP_MEMORY_SCOPE_AGENT); }
__device__ __forceinline__ unsigned xb_add(unsigned* p, unsigned v) { return __hip_atomic_fetch_add(p, v, __ATOMIC_RELAXED, __HIP_MEMORY_SCOPE_AGENT); }
__device__ __forceinline__ unsigned xb_xcc_id() { return (unsigned)__builtin_amdgcn_s_getreg((3 << 11) | 20) & 0xFu; }
#define XB_SPIN(cond, bar) do { unsigned _sp = 0; while (cond) { __builtin_amdgcn_s_sleep(1); \
    if ((++_sp & 255u) == 0u) { if (xb_ld(&(bar)[XB_TMO])) break; if (_sp > XB_SPIN_CAP) { atomicAdd(&(bar)[XB_TMO], 1u); break; } } } } while (0)
struct XcdBarrier { unsigned* bar; unsigned x; volatile LAS unsigned* st; };
__device__ __forceinline__ XcdBarrier xcd_barrier_post(unsigned* bar, volatile LAS unsigned* st) {
    XcdBarrier b; b.bar = bar; b.x = xb_xcc_id(); b.st = st;
    if (threadIdx.x == 0) (void)xb_add(&bar[XB_XCNT(b.x)], 1u);
    return b;
}
__device__ __forceinline__ void xcd_barrier_complete(unsigned* bar, unsigned x, unsigned& nloc, unsigned& nx) {
    const unsigned G = gridDim.x * gridDim.y * gridDim.z;
    unsigned sum, cnt, mine, sp = 0u;
    for (;;) {
        sum = 0u; cnt = 0u; mine = 0u;
#pragma unroll
        for (unsigned j = 0; j < 16; ++j) { const unsigned c = xb_ld(&bar[XB_XCNT(j)]); sum += c; cnt += (c > 0u) ? 1u : 0u; mine = (j == x) ? c : mine; }
        if (sum == G) break;
        __builtin_amdgcn_s_sleep(1);
        if ((++sp & 255u) == 0u) { if (xb_ld(&bar[XB_TMO])) break; if (sp > XB_SPIN_CAP) { atomicAdd(&bar[XB_TMO], 1u); break; } }
    }
    nloc = mine > 0u ? mine : 1u; nx = cnt > 0u ? cnt : 1u;
}
__device__ __forceinline__ void xcd_barrier(const XcdBarrier& b) {
    asm volatile("s_waitcnt vmcnt(0)" ::: "memory");
    __syncthreads();
    if (threadIdx.x == 0) {
        unsigned* bar = b.bar;
        __builtin_amdgcn_s_waitcnt(0);
        unsigned nloc = b.st[0], nx = b.st[1];
        if (nloc == 0u) { xcd_barrier_complete(bar, b.x, nloc, nx); b.st[0] = nloc; b.st[1] = nx; }
        const unsigned old = xb_add(&bar[XB_XSUB(b.x)], 1u);
        const unsigned gen = old / nloc;
        if (old + 1u == (gen + 1u) * nloc) {
            __builtin_amdgcn_fence(__ATOMIC_RELEASE, "agent");
            asm volatile("s_waitcnt vmcnt(0)" ::: "memory");
            const unsigned og = xb_add(&bar[XB_TOP], 1u);
            const unsigned tg = og / nx;
            if (og + 1u == (tg + 1u) * nx) xb_add(&bar[XB_TOPGEN], 1u);
            else XB_SPIN(xb_ld(&bar[XB_TOPGEN]) == tg, bar);
            __builtin_amdgcn_fence(__ATOMIC_ACQUIRE, "agent");
            xb_add(&bar[XB_XGEN(b.x)], 1u);
            asm volatile("s_waitcnt vmcnt(0)" ::: "memory");
        } else {
            XB_SPIN(xb_ld(&bar[XB_XGEN(b.x)]) == gen, bar);
            __builtin_amdgcn_fence(__ATOMIC_ACQUIRE, "agent");
            asm volatile("s_waitcnt vmcnt(0)" ::: "memory");
        }
    }
    __syncthreads();
}

namespace pg8 {
constexpr int BM = 256, BK = 64, HALF = 128, HTB = HALF * BK * 2, STAGE_BYTES = 8 * HTB, NXCD = 8, WGM = 8;
__device__ __forceinline__ int lds_byte(int r, int c) { const int st = (r >> 4) * 2 + (c >> 5), rr = r & 15, cc = c & 31, ob = rr * 64 + cc * 2; return st * 1024 + (ob ^ (((ob >> 9) & 1) << 5)); }
__device__ __forceinline__ void stage_rc(int b, int& R, int& C) { const int st = b / 1024, sb = b % 1024, swz = sb ^ (((sb >> 9) & 1) << 5); R = (st >> 1) * 16 + swz / 64; C = (st & 1) * 32 + (swz % 64) / 2; }
__device__ __forceinline__ int perm32(int rho) { const int n = rho >> 4, i = rho & 15; return 8 * (i >> 2) + 4 * n + (i & 3); }

struct Unit { int pm, pn, e, rt; };

struct StaticSched {
    int nM, nN, nwg, G, c; unsigned K2; const char* Bt;
    __device__ void init(int M, int N, int K, const void* Bt_, int G_, int c_) { nM = M / BM; nN = N / BM; nwg = nM * nN; G = G_; c = c_; K2 = (unsigned)K * 2u; Bt = (const char*)Bt_; }
    __device__ __forceinline__ bool next(int i, Unit& u) const {
        const long L = (long)i * G + c; if (L >= nwg) return false;
        int wgid = (int)L; { const int q = nwg / NXCD, r = nwg % NXCD, xcd = wgid % NXCD, off = wgid / NXCD; wgid = (xcd < r ? xcd * (q + 1) : r * (q + 1) + (xcd - r) * q) + off; }
        const int nig = WGM * nN, gid = wgid / nig, fm = gid * WGM, gsz = (nM - fm) < WGM ? (nM - fm) : WGM;
        u.pm = fm + ((wgid % nig) % gsz); u.pn = (wgid % nig) / gsz; u.e = 0; u.rt = 0; return true;
    }
    __device__ __forceinline__ unsigned aoff(int, const Unit& u, int row) const { return (unsigned)(u.pm * BM + row) * K2; }
    __device__ __forceinline__ const char* bbase() const { return Bt; }
    __device__ __forceinline__ unsigned boff(const Unit& u) const { return (unsigned)(u.pn * BM) * K2; }
};
template <bool GATHER> struct MoeSched {
    int G, v, NT, ntot; unsigned K2; const char* Bt; size_t bstride; const LAS int* tpre; const LAS unsigned* idx;
    __device__ __forceinline__ bool next(int i, Unit& u) const {
        const int U = i * G + v; if (U >= ntot * NT) return false;
        const int rtg = U / NT; u.pm = rtg; u.pn = U - rtg * NT;
        int lo = 0, hi = NE;
#pragma unroll
        for (int s = 0; s < 5; ++s) { const int mid = (lo + hi) >> 1; const int t = __builtin_amdgcn_readfirstlane(tpre[mid]); if (rtg >= t) lo = mid; else hi = mid; }
        u.e = lo; u.rt = rtg - __builtin_amdgcn_readfirstlane(tpre[lo]); return true;
    }
    __device__ __forceinline__ unsigned aoff(int i, const Unit& u, int row) const { if (GATHER) return idx[i * 256 + row]; return (unsigned)(u.pm * BM + row) * K2; }
    __device__ __forceinline__ const char* bbase() const { return Bt; }
    __device__ __forceinline__ unsigned boff(const Unit& u) const { return (unsigned)u.e * (unsigned)bstride + (unsigned)(u.pn * BM) * K2; }
};

template <class Epi, class Sched>
__device__ __forceinline__ void gemm_phase(LAS unsigned char* lds, const char* Abase, const int K, const Sched& S, const Epi& E, const int tid) {
    const int wid = __builtin_amdgcn_readfirstlane(tid >> 6), lane = tid & 63, wr = wid >> 2, wc = wid & 3, fr = lane & 15, fq = lane >> 4;
    const int nt = K / BK;
    int Rr[2]; unsigned colA[2], voffB[2];
#pragma unroll
    for (int i = 0; i < 2; ++i) { int R, C; stage_rc(tid * 16 + i * 8192, R, C); const int Rb = Epi::PERM ? ((R & ~31) + perm32(R & 31)) : R;
        Rr[i] = R; colA[i] = (unsigned)C * 2u; voffB[i] = (unsigned)(Rb * K + C) * 2u; }
    const unsigned kstep = (unsigned)(BK * 2);
    const unsigned hstep = (unsigned)HALF * (unsigned)K * 2u;
    const unsigned ldsw = (unsigned)wid * 1024u;
    const int aoff = lds_byte(wr * 64 + fr, fq * 8), boff = lds_byte(wc * 32 + fr, fq * 8);
    const __amdgpu_buffer_rsrc_t rA = __builtin_amdgcn_make_buffer_rsrc((void*)Abase, 0, 0xffffffff, 0x00020000);
    const __amdgpu_buffer_rsrc_t rB = __builtin_amdgcn_make_buffer_rsrc((void*)S.bbase(), 0, 0xffffffff, 0x00020000);
#define PG8_SA(b, h) (((b) * 2 + (h)) * HTB)
#define PG8_SB(b, h) ((4 + (b) * 2 + (h)) * HTB)
#define PG8_STAGEB(bufoff, soff) do { _Pragma("unroll") for (int _i = 0; _i < 2; ++_i) \
        __builtin_amdgcn_raw_ptr_buffer_load_lds(rB, (LAS unsigned*)(lds + (bufoff) + ldsw + _i * 8192), 16, voffB[_i], (soff), 0, 0); } while (0)
#define PG8_STAGEA(bufoff, offs, soff) do { _Pragma("unroll") for (int _i = 0; _i < 2; ++_i) \
        __builtin_amdgcn_raw_ptr_buffer_load_lds(rA, (LAS unsigned*)(lds + (bufoff) + ldsw + _i * 8192), 16, (offs)[_i], (soff), 0, 0); } while (0)
#define PG8_LDA(dst, b, h) do { _Pragma("unroll") for (int m = 0; m < 4; ++m) _Pragma("unroll") for (int k = 0; k < 2; ++k) dst[m][k] = *(const LAS bf16x8*)(lds + PG8_SA(b, h) + aoff + m * 2048 + k * 1024); } while (0)
#define PG8_LDB(dst, b, h) do { _Pragma("unroll") for (int n = 0; n < 2; ++n) _Pragma("unroll") for (int k = 0; k < 2; ++k) dst[n][k] = *(const LAS bf16x8*)(lds + PG8_SB(b, h) + boff + n * 2048 + k * 1024); } while (0)
#define PG8_MMA(ai, bj, At, Bt) do { __builtin_amdgcn_s_setprio(1); _Pragma("unroll") for (int m = 0; m < 4; ++m) _Pragma("unroll") for (int n = 0; n < 2; ++n) _Pragma("unroll") for (int k = 0; k < 2; ++k) \
        acc[ai][bj][m][n] = __builtin_amdgcn_mfma_f32_16x16x32_bf16(Bt[n][k], At[m][k], acc[ai][bj][m][n], 0, 0, 0); __builtin_amdgcn_s_setprio(0); } while (0)
#define PG8_WAIT_V(n) asm volatile("s_waitcnt vmcnt(" #n ")" ::: "memory")
#define PG8_WAIT_L(n) asm volatile("s_waitcnt lgkmcnt(" #n ")" ::: "memory")
#define PG8_BAR __builtin_amdgcn_s_barrier()
#define PG8_SCHED __builtin_amdgcn_sched_barrier(0)
#define PG8_KPAIR(K1, A20, A21, KA2, B2) do { \
            PG8_LDB(B0, 0, 0); PG8_LDB(B1, 0, 1); PG8_SCHED; PG8_LDA(At, 0, 0); PG8_STAGEA(PG8_SA(1, 1), ca1, (K1)); \
            PG8_WAIT_V(8); PG8_WAIT_L(0); PG8_BAR; PG8_MMA(0, 0, At, B0); PG8_MMA(0, 1, At, B1); PG8_BAR; PG8_SCHED; \
            PG8_LDA(At, 0, 1); PG8_STAGEB(PG8_SB(0, 0), (B2)); PG8_STAGEB(PG8_SB(0, 1), (B2) + hstep); PG8_STAGEA(PG8_SA(0, 0), A20, (KA2)); \
            PG8_WAIT_V(8); PG8_WAIT_L(0); PG8_BAR; PG8_MMA(1, 0, At, B0); PG8_MMA(1, 1, At, B1); PG8_BAR; PG8_SCHED; \
            PG8_LDB(B0, 1, 0); PG8_LDB(B1, 1, 1); PG8_SCHED; PG8_LDA(At, 1, 0); PG8_STAGEA(PG8_SA(0, 1), A21, (KA2)); \
            PG8_WAIT_V(8); PG8_WAIT_L(0); PG8_BAR; PG8_MMA(0, 0, At, B0); PG8_MMA(0, 1, At, B1); PG8_BAR; PG8_SCHED; \
            PG8_LDA(At, 1, 1); PG8_STAGEB(PG8_SB(1, 0), (B2) + kstep); PG8_STAGEB(PG8_SB(1, 1), (B2) + kstep + hstep); PG8_STAGEA(PG8_SA(1, 0), A20, (KA2) + kstep); \
            PG8_WAIT_V(8); PG8_WAIT_L(0); PG8_BAR; PG8_MMA(1, 0, At, B0); PG8_MMA(1, 1, At, B1); PG8_BAR; PG8_SCHED; } while (0)
    Unit cur, nxt; int ui = 0;
    if (!S.next(0, cur)) return;
    f32x4 acc[2][2][4][2];
#pragma unroll
    for (int a = 0; a < 2; ++a)
#pragma unroll
        for (int b = 0; b < 2; ++b)
#pragma unroll
            for (int m = 0; m < 4; ++m)
#pragma unroll
                for (int n = 0; n < 2; ++n) acc[a][b][m][n] = (f32x4){0.f, 0.f, 0.f, 0.f};
    bf16x8 At[4][2], B0[2][2], B1[2][2];
    unsigned ca0[2], ca1[2], na0[2], na1[2];
#pragma unroll
    for (int i = 0; i < 2; ++i) { ca0[i] = S.aoff(0, cur, Rr[i]) + colA[i]; ca1[i] = S.aoff(0, cur, HALF + Rr[i]) + colA[i]; }
    unsigned cB = S.boff(cur);
    PG8_STAGEB(PG8_SB(0, 0), cB); PG8_STAGEB(PG8_SB(0, 1), cB + hstep); PG8_STAGEA(PG8_SA(0, 0), ca0, 0u); PG8_STAGEA(PG8_SA(0, 1), ca1, 0u);
    if (wr == 1) PG8_BAR;
    PG8_WAIT_V(2); PG8_BAR;
    PG8_STAGEB(PG8_SB(1, 0), cB + kstep); PG8_STAGEA(PG8_SA(1, 0), ca0, kstep); PG8_STAGEB(PG8_SB(1, 1), cB + hstep + kstep);
    PG8_WAIT_V(6); PG8_BAR;
    for (;;) {
        const bool has_next = S.next(ui + 1, nxt);
        const unsigned nB = has_next ? S.boff(nxt) : cB;
#pragma unroll
        for (int i = 0; i < 2; ++i) { na0[i] = has_next ? S.aoff(ui + 1, nxt, Rr[i]) + colA[i] : ca0[i]; na1[i] = has_next ? S.aoff(ui + 1, nxt, HALF + Rr[i]) + colA[i] : ca1[i]; }
        for (int t = 0; t < nt - 2; t += 2) { const unsigned k1 = (unsigned)(t + 1) * kstep, k2 = (unsigned)(t + 2) * kstep; PG8_KPAIR(k1, ca0, ca1, k2, cB + k2); }
        { const unsigned k1 = (unsigned)(nt - 1) * kstep; PG8_KPAIR(k1, na0, na1, 0u, nB); }
        if (wr == 0) PG8_BAR;
        E(acc, cur, wr, wc, fr, fq);
        if (!has_next) break;
#pragma unroll
        for (int a = 0; a < 2; ++a)
#pragma unroll
            for (int b = 0; b < 2; ++b)
#pragma unroll
                for (int m = 0; m < 4; ++m)
#pragma unroll
                    for (int n = 0; n < 2; ++n) acc[a][b][m][n] = (f32x4){0.f, 0.f, 0.f, 0.f};
        cur = nxt; cB = nB; ++ui;
#pragma unroll
        for (int i = 0; i < 2; ++i) { ca0[i] = na0[i]; ca1[i] = na1[i]; }
        if (wr == 1) PG8_BAR;
    }
    PG8_WAIT_V(0);
    PG8_BAR;
#undef PG8_KPAIR
#undef PG8_SA
#undef PG8_SB
#undef PG8_STAGEA
#undef PG8_STAGEB
#undef PG8_LDA
#undef PG8_LDB
#undef PG8_MMA
#undef PG8_WAIT_V
#undef PG8_WAIT_L
#undef PG8_BAR
#undef PG8_SCHED
}

struct EpiIn {
    static constexpr bool PERM = true;
    bf16 *Q, *Kh, *VT, *HCV; const float *qg, *kg;
    __device__ __forceinline__ void operator()(const f32x4 (&acc)[2][2][4][2], const Unit& u, int wr, int wc, int fr, int fq) const {
        const int pn = u.pn;
        const int row0 = u.pm * BM + wr * 64 + fr;
        if (pn < 4) {
            const bool isq = pn < 2; const float* g = isq ? qg : kg; const float sc = isq ? QSCALE : 1.0f;
            const int head = 4 * (pn & 1) + wc;
            f32x4 gv[2][2];
#pragma unroll
            for (int bj = 0; bj < 2; ++bj)
#pragma unroll
                for (int n = 0; n < 2; ++n) gv[bj][n] = *(const f32x4*)(g + 32 * bj + 8 * fq + 4 * n) * sc;
#pragma unroll
            for (int ai = 0; ai < 2; ++ai)
#pragma unroll
                for (int m = 0; m < 4; ++m) {
                    float ss = 0.f;
#pragma unroll
                    for (int bj = 0; bj < 2; ++bj)
#pragma unroll
                        for (int n = 0; n < 2; ++n) { const f32x4 x = acc[ai][bj][m][n]; ss += (x[0] * x[0] + x[1] * x[1]) + (x[2] * x[2] + x[3] * x[3]); }
                    ss += __shfl_xor(ss, 16); ss += __shfl_xor(ss, 32);
                    const float rs = __builtin_amdgcn_rsqf(ss * (1.0f / 64.0f) + EPS);
                    const int row = row0 + ai * HALF + m * 16, b = row >> 12, t = row & 4095;
                    bf16* dst = isq ? Q + ((size_t)(b * NH + head) * SEQ + t) * HD : Kh + ((size_t)(b * NH + head) * LP + 32 + t) * HD;
#pragma unroll
                    for (int bj = 0; bj < 2; ++bj) { const f32x4 v0 = acc[ai][bj][m][0] * rs * gv[bj][0], v1 = acc[ai][bj][m][1] * rs * gv[bj][1];
                        u32x4 w; w.x = cvt_pk_bf16(v0[0], v0[1]); w.y = cvt_pk_bf16(v0[2], v0[3]); w.z = cvt_pk_bf16(v1[0], v1[1]); w.w = cvt_pk_bf16(v1[2], v1[3]);
                        *(u32x4*)(dst + 32 * bj + 8 * fq) = w; }
                }
        } else if (pn < 6) {
            const int head = 4 * (pn & 1) + wc;
#pragma unroll
            for (int ai = 0; ai < 2; ++ai)
#pragma unroll
                for (int m = 0; m < 4; ++m) {
                    const int row = row0 + ai * HALF + m * 16, b = row >> 12, t = row & 4095;
                    bf16* dst = VT + ((size_t)(b * NH + head) * HD) * LP + 32 + t;
#pragma unroll
                    for (int bj = 0; bj < 2; ++bj)
#pragma unroll
                        for (int n = 0; n < 2; ++n)
#pragma unroll
                            for (int e = 0; e < 4; ++e) dst[(size_t)(32 * bj + 8 * fq + 4 * n + e) * LP] = f2bf(acc[ai][bj][m][n][e]);
                }
        } else {
            const int ch0 = 128 * (pn - 6) + 32 * wc + 8 * fq;
#pragma unroll
            for (int ai = 0; ai < 2; ++ai)
#pragma unroll
                for (int m = 0; m < 4; ++m) {
                    const int row = row0 + ai * HALF + m * 16, b = row >> 12, t = row & 4095;
                    f32x4 h0, h1;
#pragma unroll
                    for (int e = 0; e < 4; ++e) { h0[e] = acc[ai][0][m][0][e] * sigmoidf_(acc[ai][1][m][0][e]); h1[e] = acc[ai][0][m][1][e] * sigmoidf_(acc[ai][1][m][1][e]); }
                    u32x4 w; w.x = cvt_pk_bf16(h0[0], h0[1]); w.y = cvt_pk_bf16(h0[2], h0[3]); w.z = cvt_pk_bf16(h1[0], h1[1]); w.w = cvt_pk_bf16(h1[2], h1[3]);
                    *(u32x4*)(HCV + ((size_t)b * LP + 32 + t) * CW + ch0) = w;
                }
        }
    }
};
struct EpiRes {
    static constexpr bool PERM = false;
    const float* X; float* O;
    __device__ __forceinline__ void operator()(const f32x4 (&acc)[2][2][4][2], const Unit& u, int wr, int wc, int fr, int fq) const {
        const int row0 = u.pm * BM + wr * 64 + fr, col0 = u.pn * BM + wc * 32 + 4 * fq;
#pragma unroll
        for (int ai = 0; ai < 2; ++ai)
#pragma unroll
            for (int m = 0; m < 4; ++m) { const size_t off = (size_t)(row0 + ai * HALF + m * 16) * DM + col0;
#pragma unroll
                for (int bj = 0; bj < 2; ++bj)
#pragma unroll
                    for (int n = 0; n < 2; ++n) { const f32x4 xv = *(const f32x4*)(X + off + bj * HALF + n * 16); *(f32x4*)(O + off + bj * HALF + n * 16) = xv + acc[ai][bj][m][n]; } }
    }
};
struct EpiUp {
    static constexpr bool PERM = true;
    bf16* ACT; const float* bup;
    __device__ __forceinline__ void operator()(const f32x4 (&acc)[2][2][4][2], const Unit& u, int wr, int wc, int fr, int fq) const {
        const int c0 = 128 * u.pn + 32 * wc + 8 * fq;
        const float* bb = bup + (size_t)u.e * 2048 + c0;
        const f32x4 bg0 = *(const f32x4*)(bb), bg1 = *(const f32x4*)(bb + 4), bl0 = *(const f32x4*)(bb + 1024), bl1 = *(const f32x4*)(bb + 1028);
        const int row0 = u.pm * BM + wr * 64 + fr;
#pragma unroll
        for (int ai = 0; ai < 2; ++ai)
#pragma unroll
            for (int m = 0; m < 4; ++m) {
                const f32x4 g0 = acc[ai][0][m][0] + bg0, g1 = acc[ai][0][m][1] + bg1, l0 = acc[ai][1][m][0] + bl0, l1 = acc[ai][1][m][1] + bl1;
                f32x4 a0, a1;
#pragma unroll
                for (int e = 0; e < 4; ++e) {
                    const float ga = fminf(g0[e], SW_LIMIT), la = fminf(fmaxf(l0[e], -SW_LIMIT), SW_LIMIT); a0[e] = ga * sigmoidf_(SW_ALPHA * ga) * (la + 1.0f);
                    const float gb = fminf(g1[e], SW_LIMIT), lb = fminf(fmaxf(l1[e], -SW_LIMIT), SW_LIMIT); a1[e] = gb * sigmoidf_(SW_ALPHA * gb) * (lb + 1.0f); }
                u32x4 w; w.x = cvt_pk_bf16(a0[0], a0[1]); w.y = cvt_pk_bf16(a0[2], a0[3]); w.z = cvt_pk_bf16(a1[0], a1[1]); w.w = cvt_pk_bf16(a1[2], a1[3]);
                *(u32x4*)(ACT + (size_t)(row0 + ai * HALF + m * 16) * DE + c0) = w;
            }
    }
};
struct EpiDown {
    static constexpr bool PERM = true;
    bf16* Y; const float* bdn; const float* rgate;
    __device__ __forceinline__ void operator()(const f32x4 (&acc)[2][2][4][2], const Unit& u, int wr, int wc, int fr, int fq) const {
        const int c0 = u.pn * BM + wc * 32 + 8 * fq;
        const float* bb = bdn + (size_t)u.e * DM + c0;
        f32x4 bv[2][2];
#pragma unroll
        for (int bj = 0; bj < 2; ++bj)
#pragma unroll
            for (int n = 0; n < 2; ++n) bv[bj][n] = *(const f32x4*)(bb + bj * HALF + 4 * n);
        const int lrow0 = wr * 64 + fr;
        const float* gp = rgate + (size_t)u.e * CAP + u.rt * BM;
#pragma unroll
        for (int ai = 0; ai < 2; ++ai)
#pragma unroll
            for (int m = 0; m < 4; ++m) {
                const int lr = lrow0 + ai * HALF + m * 16; const float gt = gp[lr];
                bf16* rowp = Y + (size_t)(u.pm * BM + lr) * DM + c0;
#pragma unroll
                for (int bj = 0; bj < 2; ++bj) { const f32x4 v0 = (acc[ai][bj][m][0] + bv[bj][0]) * gt, v1 = (acc[ai][bj][m][1] + bv[bj][1]) * gt;
                    u32x4 w; w.x = cvt_pk_bf16(v0[0], v0[1]); w.y = cvt_pk_bf16(v0[2], v0[3]); w.z = cvt_pk_bf16(v1[0], v1[1]); w.w = cvt_pk_bf16(v1[2], v1[3]);
                    *(u32x4*)(rowp + bj * HALF) = w; }
            }
    }
};
}

struct Frame {
    LAS unsigned char* lds; LAS unsigned char* aux;
    gu32* ctl;
    int tid, lane, wave, vcu, G;
    const float *x, *meta, *g1, *w_in, *qg, *kg, *conv_w, *conv_b, *ln_g, *ln_b, *og, *w_out, *g2, *w_r, *b_r, *w_up, *b_up, *w_dn, *b_dn;
    float* out;
    bf16 *WinT, *WoT, *WdT, *WupT, *NM, *Q, *Kh, *VT, *HCV, *HN, *ACT, *Y;
    int* rtok; float* rgate; unsigned* tslot;
};

__device__ __forceinline__ int win_dest(int n0) {
    if (n0 < 1536) { const int tile = n0 >> 8, s = n0 & 255, wc = s >> 6, bj = (s >> 5) & 1; return tile * 256 + 128 * bj + 32 * wc; }
    if (n0 < 2048) { const int j = n0 - 1536; return 1536 + 256 * (j >> 7) + (j & 127); }
    const int j = n0 - 2048; return 1536 + 256 * (j >> 7) + 128 + (j & 127);
}
__device__ __forceinline__ int wup_dest(int n0) { if (n0 < 1024) return 256 * (n0 >> 7) + (n0 & 127); const int j = n0 - 1024; return 256 * (j >> 7) + 128 + (j & 127); }
struct TrItem { const float* src; const float* g; bf16* dst; int N; };
__device__ __forceinline__ void tr_load(const TrItem& t, f32x4 (&v)[8], float (&gv)[8], int lane) {
    const int kr = lane >> 3, nc = (lane & 7) * 4;
#pragma unroll
    for (int i = 0; i < 8; ++i) { v[i] = *(const f32x4*)(t.src + (size_t)(8 * i + kr) * t.N + nc); gv[i] = t.g ? t.g[8 * i + kr] : 1.0f; }
}
__device__ __forceinline__ void tr_store(const TrItem& t, const f32x4 (&v)[8], const float (&gv)[8], LAS float* scr, int lane) {
    const int kr = lane >> 3, nc = (lane & 7) * 4;
#pragma unroll
    for (int i = 0; i < 8; ++i) { LAS float* d = scr + (8 * i + kr) * 33 + nc; d[0] = v[i].x * gv[i]; d[1] = v[i].y * gv[i]; d[2] = v[i].z * gv[i]; d[3] = v[i].w * gv[i]; }
    LDS_WAIT(); asm volatile("" ::: "memory");
    const int c = lane & 7;
#pragma unroll
    for (int j = 0; j < 4; ++j) { const int n = (lane >> 3) + 8 * j; const LAS float* q = scr + (8 * c) * 33 + n;
        u32x4 o; o.x = cvt_pk_bf16(q[0 * 33], q[1 * 33]); o.y = cvt_pk_bf16(q[2 * 33], q[3 * 33]); o.z = cvt_pk_bf16(q[4 * 33], q[5 * 33]); o.w = cvt_pk_bf16(q[6 * 33], q[7 * 33]);
        *(u32x4*)(t.dst + (size_t)n * 1024 + 8 * c) = o; }
    LDS_WAIT(); asm volatile("" ::: "memory");
}
__device__ __forceinline__ void meta_unit(Frame& F, int mu) {
    LAS float* nmT = (LAS float*)F.lds;
    LAS float* part = (LAS float*)(F.lds + 65536);
    LAS float* rs = (LAS float*)(F.aux + A_RED);
    const int type = mu >> 3, hh = mu & 7, lane = F.lane, w = F.wave;
    for (int r = 2 * w; r < 2 * w + 2; ++r) { float s = 0.f; for (int k = lane; k < DM; k += 64) { const float v = F.meta[r * DM + k]; s += v * v; } s = wave_sum(s); if (lane == 0) rs[r] = __builtin_amdgcn_rsqf(s * (1.0f / DM) + EPS); }
    __syncthreads();
    for (int idx = F.tid; idx < NMETA * DM; idx += 512) { const int r = idx >> 10, k = idx & 1023; nmT[k * 16 + r] = F.meta[idx] * rs[r] * F.g1[k]; }
    __syncthreads();
    const int col = (type == 0 ? 512 : type == 1 ? 1024 : 1536) + 64 * hh + lane, colg = 2048 + 64 * hh + lane;
    float a1[16], a2[16];
#pragma unroll
    for (int r = 0; r < 16; ++r) { a1[r] = 0.f; a2[r] = 0.f; }
    for (int k = 128 * w; k < 128 * w + 128; ++k) {
        const float wv = F.w_in[(size_t)k * INC + col]; const float wg = (type == 2) ? F.w_in[(size_t)k * INC + colg] : 0.f;
        const LAS f32x4* np = (const LAS f32x4*)(nmT + k * 16);
#pragma unroll
        for (int q = 0; q < 4; ++q) { const f32x4 nv = np[q];
#pragma unroll
            for (int e = 0; e < 4; ++e) { a1[4 * q + e] += nv[e] * wv; a2[4 * q + e] += nv[e] * wg; } }
    }
#pragma unroll
    for (int r = 0; r < 16; ++r) { part[(w * 16 + r) * 64 + lane] = a1[r]; part[8192 + (w * 16 + r) * 64 + lane] = a2[r]; }
    __syncthreads();
    for (int r = 2 * w; r < 2 * w + 2; ++r) {
        float v = 0.f, v2 = 0.f;
#pragma unroll
        for (int ww = 0; ww < 8; ++ww) { v += part[(ww * 16 + r) * 64 + lane]; v2 += part[8192 + (ww * 16 + r) * 64 + lane]; }
        if (type == 0) { const float ss = wave_sum(v * v); const bf16 o = f2bf(v * __builtin_amdgcn_rsqf(ss * (1.0f / 64.0f) + EPS) * F.kg[lane]);
            for (int b = 0; b < NB; ++b) F.Kh[((size_t)(b * NH + hh) * LP + LPAD + r) * HD + lane] = o; }
        else if (type == 1) { const bf16 o = f2bf(v); for (int b = 0; b < NB; ++b) F.VT[((size_t)(b * NH + hh) * HD + lane) * LP + LPAD + r] = o; }
        else { const bf16 o = f2bf(v * sigmoidf_(v2)); for (int b = 0; b < NB; ++b) F.HCV[((size_t)b * LP + LPAD + r) * CW + 64 * hh + lane] = o; }
    }
    __syncthreads();
}
__device__ __forceinline__ void p0_prologue(Frame& F) {
    if (F.vcu < 24) meta_unit(F, F.vcu);
    for (int mu = F.vcu + F.G; mu < 24; mu += F.G) meta_unit(F, mu);
    LAS float* scr = (LAS float*)(F.lds + F.wave * 16384);
    const int gw = F.vcu * NWAVES + F.wave, NGW = F.G * NWAVES, lane = F.lane;
    for (int it = gw; it < 192; it += NGW) {
        const u32x4 z = (u32x4){0u, 0u, 0u, 0u};
        if (it < 64) { u32x4* p = (u32x4*)(F.Kh + (size_t)it * LP * HD); p[lane] = z; p[64 + lane] = z; }
        else if (it < 128) { u32x4* p = (u32x4*)(F.VT + ((size_t)(it - 64) * HD + lane) * LP); p[0] = z; p[1] = z; }
        else { const int j = it - 128, b = j >> 3, rr = (j & 7) * 2; u32x4* p = (u32x4*)(F.HCV + ((size_t)b * LP + rr) * CW); p[lane] = z; p[64 + lane] = z; }
    }
    constexpr int I_IN = 16 * 80, I_O = 16 * 32, I_UP = NE * 16 * 64, I_DN = NE * 16 * 32, NITEMS = I_IN + I_O + I_UP + I_DN;
    auto decode = [&](int it, TrItem& t) {
        int r = it;
        if (r < I_IN) { const int kb = r / 80, nb = r % 80; t.src = F.w_in + (size_t)(64 * kb) * INC + 32 * nb; t.N = INC; t.g = F.g1 + 64 * kb; t.dst = F.WinT + (size_t)win_dest(32 * nb) * 1024 + 64 * kb; return; } r -= I_IN;
        if (r < I_O) { const int kb = r / 32, nb = r % 32; t.src = F.w_out + (size_t)(64 * kb) * DM + 32 * nb; t.N = DM; t.g = nullptr; t.dst = F.WoT + (size_t)(32 * nb) * 1024 + 64 * kb; return; } r -= I_O;
        if (r < I_UP) { const int e = r >> 10, rr = r & 1023, kb = rr >> 6, nb = rr & 63; t.src = F.w_up + (size_t)e * DM * 2048 + (size_t)(64 * kb) * 2048 + 32 * nb; t.N = 2048; t.g = F.g2 + 64 * kb;
            t.dst = F.WupT + ((size_t)e * 2048 + wup_dest(32 * nb)) * 1024 + 64 * kb; return; } r -= I_UP;
        { const int e = r >> 9, rr = r & 511, kb = rr >> 5, nb = rr & 31; t.src = F.w_dn + (size_t)e * DE * DM + (size_t)(64 * kb) * DM + 32 * nb; t.N = DM; t.g = nullptr;
            t.dst = F.WdT + ((size_t)e * DM + 32 * nb) * 1024 + 64 * kb; }
    };
    {
        TrItem cur, nx; f32x4 va[8], vb[8]; float ga[8], gb[8];
        int it = gw;
        if (it < NITEMS) { decode(it, cur); tr_load(cur, va, ga, lane); }
        while (it < NITEMS) {
            const int nit = it + NGW;
            if (nit < NITEMS) { decode(nit, nx); tr_load(nx, vb, gb, lane); }
            tr_store(cur, va, ga, scr, lane);
            cur = nx; it = nit;
#pragma unroll
            for (int i = 0; i < 8; ++i) { va[i] = vb[i]; ga[i] = gb[i]; }
        }
    }
    for (int m = gw; m < NTOK; m += 2 * NGW) {
        const int m2 = (m + NGW < NTOK) ? m + NGW : m;
        const f32x4* xr = (const f32x4*)(F.x + (size_t)m * DM) + lane; const f32x4* xr2 = (const f32x4*)(F.x + (size_t)m2 * DM) + lane;
        f32x4 v[4], w[4]; float s = 0.f, s2 = 0.f;
#pragma unroll
        for (int j = 0; j < 4; ++j) { v[j] = xr[64 * j]; w[j] = xr2[64 * j]; }
#pragma unroll
        for (int j = 0; j < 4; ++j) { s += (v[j].x * v[j].x + v[j].y * v[j].y) + (v[j].z * v[j].z + v[j].w * v[j].w); s2 += (w[j].x * w[j].x + w[j].y * w[j].y) + (w[j].z * w[j].z + w[j].w * w[j].w); }
        const float rstd = __builtin_amdgcn_rsqf(wave_sum(s) * (1.0f / DM) + EPS), rstd2 = __builtin_amdgcn_rsqf(wave_sum(s2) * (1.0f / DM) + EPS);
        u32x2* o8 = (u32x2*)(F.NM + (size_t)m * DM) + lane; u32x2* o82 = (u32x2*)(F.NM + (size_t)m2 * DM) + lane;
#pragma unroll
        for (int j = 0; j < 4; ++j) { u32x2 o; o.x = cvt_pk_bf16(v[j].x * rstd, v[j].y * rstd); o.y = cvt_pk_bf16(v[j].z * rstd, v[j].w * rstd); o8[64 * j] = o;
            u32x2 o2; o2.x = cvt_pk_bf16(w[j].x * rstd2, w[j].y * rstd2); o2.y = cvt_pk_bf16(w[j].z * rstd2, w[j].w * rstd2); o82[64 * j] = o2; }
    }
}

__device__ __forceinline__ void conv_phase(Frame& F) {
    const int c = F.tid, lane = F.lane;
    LAS float* red = (LAS float*)(F.aux + A_RED); LAS float* tot = (LAS float*)(F.aux + A_TOT);
    float w[CKW];
#pragma unroll
    for (int j = 0; j < CKW; ++j) w[j] = F.conv_w[j * CW + c];
    const float cb = F.conv_b[c], lg = F.ln_g[c], lb = F.ln_b[c];
    for (int u = F.vcu; u < NTOK / 16; u += F.G) {
        const int t0 = u * 16, b = t0 >> 12, tb = t0 & 4095;
        const bf16* hp = F.HCV + ((size_t)b * LP + tb + 2) * CW + c;
        float h[46];
#pragma unroll
        for (int i = 0; i < 46; ++i) h[i] = bf2f(hp[(size_t)i * CW]);
        float v[16], rr[32];
#pragma unroll
        for (int j = 0; j < 16; ++j) { float s = cb;
#pragma unroll
            for (int k = 0; k < CKW; ++k) s += w[k] * h[j + k];
            v[j] = s; rr[j] = s; rr[16 + j] = s * s; }
        wave_reduce32(rr);
        if ((lane & 15) == 0) {
#pragma unroll
            for (int i = 0; i < 8; ++i) red[F.wave * 32 + 8 * (lane >> 4) + i] = rr[i]; }
        __syncthreads();
        if (F.tid < 32) { float s = 0.f;
#pragma unroll
            for (int ww = 0; ww < 8; ++ww) s += red[ww * 32 + F.tid]; tot[F.tid] = s; }
        __syncthreads();
#pragma unroll
        for (int j = 0; j < 16; ++j) { const float mean = tot[j] * (1.0f / CW), var = fmaxf(tot[16 + j] * (1.0f / CW) - mean * mean, 0.f);
            const float y = (v[j] - mean) * __builtin_amdgcn_rsqf(var + EPS) * lg + lb;
            F.NM[(size_t)(t0 + j) * DM + SBW + c] = f2bf(y * sigmoidf_(y)); }
    }
}

template <bool EARLY>
__device__ __forceinline__ void attn_wave_unit(Frame& F, int bh, int qb, LAS float* stg) {
    const int lane = F.lane, r = lane & 31, hf = lane >> 5;
    const bf16* qp = F.Q + ((size_t)bh * SEQ + qb * 32 + r) * HD + 8 * hf;
    bf16x8 qf[4];
#pragma unroll
    for (int s = 0; s < 4; ++s) qf[s] = *(const bf16x8*)(qp + 16 * s);
    const int krow = (r & ~12) | ((r & 4) << 1) | ((r & 8) >> 1);
    const bf16* kp = F.Kh + ((size_t)bh * LP + krow) * HD + 8 * hf;
    const bf16* vp = F.VT + ((size_t)bh * HD + r) * LP + 8 * hf;
    f32x16 o0, o1;
#pragma unroll
    for (int i = 0; i < 16; ++i) { o0[i] = 0.f; o1[i] = 0.f; }
    float C = 1.0f;
    int jb = qb + 1;
    bf16x8 kf[4], vf[4], kn[4], vn[4];
#define LOADKV(KF, VF, J) do { _Pragma("unroll") for (int s = 0; s < 4; ++s) KF[s] = *(const bf16x8*)(kp + (size_t)(J) * 32 * HD + 16 * s); \
        _Pragma("unroll") for (int d = 0; d < 2; ++d) _Pragma("unroll") for (int s = 0; s < 2; ++s) VF[d * 2 + s] = *(const bf16x8*)(vp + (size_t)d * 32 * LP + (J) * 32 + 16 * s); } while (0)
    LOADKV(kf, vf, jb);
    for (;;) {
        const int jn = jb > 0 ? jb - 1 : 0;
        LOADKV(kn, vn, jn);
        f32x16 st;
#pragma unroll
        for (int i = 0; i < 16; ++i) st[i] = 0.f;
#pragma unroll
        for (int s = 0; s < 4; ++s) st = __builtin_amdgcn_mfma_f32_32x32x16_bf16(kf[s], qf[s], st, 0, 0, 0);
        const bool diag = (jb == qb + 1), first = (jb == 0);
        float be[16], ke[16];
#pragma unroll
        for (int i = 0; i < 16; ++i) {
            const int c = 16 * (i >> 3) + 8 * hf + (i & 7);
            const float u = fast_exp2(-st[i]);
            const float bt = fast_rcp(1.0f + u);
            const bool valid = diag ? (c < r) : (first ? (c >= 16) : true);
            be[i] = valid ? bt : 0.f; ke[i] = valid ? u * bt : 1.0f;
        }
        float plo = ke[0], phi = ke[8];
#pragma unroll
        for (int i = 1; i < 8; ++i) { plo *= ke[i]; phi *= ke[8 + i]; }
        const float plo_o = __shfl_xor(plo, 32), phi_o = __shfl_xor(phi, 32);
        const float X1 = phi * phi_o, X0 = plo * plo_o, CX1 = C * X1;
        float run = hf ? C : C * phi_o;
        float a[16];
#pragma unroll
        for (int i = 15; i >= 8; --i) { a[i] = be[i] * run; run *= ke[i]; }
        run = hf ? CX1 : CX1 * plo_o;
#pragma unroll
        for (int i = 7; i >= 0; --i) { a[i] = be[i] * run; run *= ke[i]; }
        C = CX1 * X0;
        u32x4 p0, p1;
        p0.x = cvt_pk_bf16(a[0], a[1]); p0.y = cvt_pk_bf16(a[2], a[3]); p0.z = cvt_pk_bf16(a[4], a[5]); p0.w = cvt_pk_bf16(a[6], a[7]);
        p1.x = cvt_pk_bf16(a[8], a[9]); p1.y = cvt_pk_bf16(a[10], a[11]); p1.z = cvt_pk_bf16(a[12], a[13]); p1.w = cvt_pk_bf16(a[14], a[15]);
        const bf16x8 af0 = __builtin_bit_cast(bf16x8, p0), af1 = __builtin_bit_cast(bf16x8, p1);
        o0 = __builtin_amdgcn_mfma_f32_32x32x16_bf16(af0, vf[0], o0, 0, 0, 0); o0 = __builtin_amdgcn_mfma_f32_32x32x16_bf16(af1, vf[1], o0, 0, 0, 0);
        o1 = __builtin_amdgcn_mfma_f32_32x32x16_bf16(af0, vf[2], o1, 0, 0, 0); o1 = __builtin_amdgcn_mfma_f32_32x32x16_bf16(af1, vf[3], o1, 0, 0, 0);
        if (jb == 0) break;
        if (EARLY) { if (__all(C < ATTN_CUT)) break; }
        --jb;
#pragma unroll
        for (int s = 0; s < 4; ++s) { kf[s] = kn[s]; vf[s] = vn[s]; }
    }
#undef LOADKV
#pragma unroll
    for (int i = 0; i < 16; ++i) { const int q = (i & 3) + 8 * (i >> 2) + 4 * hf; stg[q * 68 + r] = o0[i]; stg[q * 68 + 32 + r] = o1[i]; }
    LDS_WAIT(); asm volatile("" ::: "memory");
    const int q = lane >> 1, half = lane & 1, h = bh & 7, b = bh >> 3;
    f32x4 v[8]; float ss = 0.f;
#pragma unroll
    for (int j = 0; j < 8; ++j) { v[j] = *(const LAS f32x4*)(stg + q * 68 + 32 * half + 4 * j); ss += (v[j].x * v[j].x + v[j].y * v[j].y) + (v[j].z * v[j].z + v[j].w * v[j].w); }
    ss += __shfl_xor(ss, 1);
    const float rstd = __builtin_amdgcn_rsqf(ss * (1.0f / 64.0f) + EPS);
    const float* gp = F.og + h * HD + 32 * half;
    bf16* dst = F.NM + ((size_t)(b * SEQ + qb * 32 + q)) * DM + h * HD + 32 * half;
#pragma unroll
    for (int j = 0; j < 4; ++j) { const f32x4 g0 = *(const f32x4*)(gp + 8 * j), g1 = *(const f32x4*)(gp + 8 * j + 4); const f32x4 a0 = v[2 * j] * rstd * g0, a1 = v[2 * j + 1] * rstd * g1;
        u32x4 w; w.x = cvt_pk_bf16(a0[0], a0[1]); w.y = cvt_pk_bf16(a0[2], a0[3]); w.z = cvt_pk_bf16(a1[0], a1[1]); w.w = cvt_pk_bf16(a1[2], a1[3]);
        *(u32x4*)(dst + 8 * j) = w; }
    LDS_WAIT(); asm volatile("" ::: "memory");
}
__device__ __forceinline__ void attn_phase(Frame& F) {
    LAS float* stg = (LAS float*)(F.lds + F.wave * 8704);
    for (int wu = F.vcu; wu < 64 * 16; wu += F.G) {
        const int bh = wu & 63, j = wu >> 6;
        const int i = j >> 2, j0 = j & 3;
        const int grp = (i == 0) ? j0 : (i == 1) ? 15 - j0 : (i == 2) ? 4 + j0 : 11 - j0;
        attn_wave_unit<ATTN_EARLY != 0>(F, bh, grp * 8 + F.wave, stg);
    }
}

template <int MODE> __device__ __forceinline__ void router_phase(Frame& F, const bool commit) {
    LAS float* Wt = (LAS float*)F.lds;
    LAS int* hist = (LAS int*)(F.aux + A_HIST); LAS int* base = (LAS int*)(F.aux + A_BASE);
    LAS int* sel_e = (LAS int*)(F.aux + A_SELE); LAS float* sel_g = (LAS float*)(F.aux + A_SELG); LAS int* rank = (LAS int*)(F.aux + A_RANK);
    const int lane = F.lane;
    if (!(MODE & 4)) {
#pragma unroll 8
    for (int idx = F.tid; idx < NE * DM; idx += 512) { const int k = idx >> 5, e = idx & 31; Wt[e * 1024 + k] = F.w_r[idx] * F.g2[k]; } }
    __syncthreads();
    const float br_me = F.b_r[lane >> 1];
    for (int blk = F.vcu; blk < NTOK / 128; blk += F.G) {
        if (F.tid < 32) hist[F.tid] = 0;
        f32x4 xn[4];
        { const f32x4* xr0 = (const f32x4*)(F.out + (size_t)(blk * 128 + F.wave * 16) * DM) + lane;
#pragma unroll
          for (int j = 0; j < 4; ++j) xn[j] = xr0[64 * j]; }
        for (int tl = F.wave * 16; tl < F.wave * 16 + 16; ++tl) {
            const int t = blk * 128 + tl;
            f32x4 xv[4]; float s = 0.f;
#pragma unroll
            for (int j = 0; j < 4; ++j) { xv[j] = xn[j]; s += (xv[j].x * xv[j].x + xv[j].y * xv[j].y) + (xv[j].z * xv[j].z + xv[j].w * xv[j].w); }
            { const int tn = (tl + 1 < F.wave * 16 + 16) ? t + 1 : t; const f32x4* xr1 = (const f32x4*)(F.out + (size_t)tn * DM) + lane;
#pragma unroll
              for (int j = 0; j < 4; ++j) xn[j] = xr1[64 * j]; }
            const float rstd = __builtin_amdgcn_rsqf(wave_sum(s) * (1.0f / DM) + EPS);
            u32x2* o8 = (u32x2*)(F.HN + (size_t)t * DM) + lane;
#pragma unroll
            for (int j = 0; j < 4; ++j) { u32x2 o; o.x = cvt_pk_bf16(xv[j].x * rstd, xv[j].y * rstd); o.y = cvt_pk_bf16(xv[j].z * rstd, xv[j].w * rstd); o8[64 * j] = o; }
            if (MODE & 8) { if (lane == 0) sel_e[tl * 4] = (int)rstd; continue; }
            float acc[32];
#pragma unroll
            for (int eb = 0; eb < 8; ++eb) {
#pragma unroll
                for (int e = 4 * eb; e < 4 * eb + 4; ++e) { float a = 0.f;
                    if (MODE & 1) { acc[e] = xv[e & 3].x * (float)e; continue; }
#pragma unroll
                    for (int j = 0; j < 4; ++j) { const f32x4 wv = *(const LAS f32x4*)(Wt + e * 1024 + 256 * j + 4 * lane); a += (xv[j].x * wv.x + xv[j].y * wv.y) + (xv[j].z * wv.z + xv[j].w * wv.w); }
                    acc[e] = a; }
                __builtin_amdgcn_sched_barrier(0);
            }
            const int e_me = lane >> 1;
            wave_reduce32(acc);
            float mine = acc[0];
#pragma unroll
            for (int i = 1; i < 8; ++i) mine = (((lane >> 1) & 7) == i) ? acc[i] : mine;
            float val = mine * rstd + br_me;
            int se[4]; float sv[4];
#pragma unroll
            for (int k = 0; k < 4; ++k) {
                if (MODE & 2) { se[k] = (lane + k) & 31; sv[k] = val; continue; }
                float bv = val; int bi = e_me;
#define RT_STEP(OV, OI) do { const float ov_ = (OV); const int oi_ = (OI); if (ov_ > bv || (ov_ == bv && oi_ < bi)) { bv = ov_; bi = oi_; } } while (0)
                RT_STEP(dpp_f<DPP_ROW_MIRROR>(bv), dpp_i<DPP_ROW_MIRROR>(bi));
                RT_STEP(dpp_f<DPP_ROW_HALF_MIRROR>(bv), dpp_i<DPP_ROW_HALF_MIRROR>(bi));
                RT_STEP(dpp_f<DPP_QUAD_REV>(bv), dpp_i<DPP_QUAD_REV>(bi));
                { const auto rv = __builtin_amdgcn_permlane16_swap(__float_as_uint(bv), __float_as_uint(bv), false, false); const auto ri = __builtin_amdgcn_permlane16_swap((unsigned)bi, (unsigned)bi, false, false);
                  float v0 = __uint_as_float(rv[0]), v1 = __uint_as_float(rv[1]); int i0 = (int)ri[0], i1 = (int)ri[1];
                  if (v1 > v0 || (v1 == v0 && i1 < i0)) { v0 = v1; i0 = i1; } bv = v0; bi = i0; }
                { const auto rv = __builtin_amdgcn_permlane32_swap(__float_as_uint(bv), __float_as_uint(bv), false, false); const auto ri = __builtin_amdgcn_permlane32_swap((unsigned)bi, (unsigned)bi, false, false);
                  float v0 = __uint_as_float(rv[0]), v1 = __uint_as_float(rv[1]); int i0 = (int)ri[0], i1 = (int)ri[1];
                  if (v1 > v0 || (v1 == v0 && i1 < i0)) { v0 = v1; i0 = i1; } bv = v0; bi = i0; }
#undef RT_STEP
                se[k] = bi; sv[k] = bv; if (e_me == bi) val = -INFINITY;
            }
            const float e1 = __expf(sv[1] - sv[0]), e2 = __expf(sv[2] - sv[0]), e3 = __expf(sv[3] - sv[0]); const float inv = 1.0f / (1.0f + e1 + e2 + e3);
            if (lane == 0) { sel_e[tl * 4 + 0] = se[0]; sel_e[tl * 4 + 1] = se[1]; sel_e[tl * 4 + 2] = se[2]; sel_e[tl * 4 + 3] = se[3];
                sel_g[tl * 4 + 0] = inv; sel_g[tl * 4 + 1] = e1 * inv; sel_g[tl * 4 + 2] = e2 * inv; sel_g[tl * 4 + 3] = e3 * inv; }
        }
        __syncthreads();
        const int a = F.tid, ea = sel_e[a];
        rank[a] = __hip_atomic_fetch_add(hist + ea, 1, __ATOMIC_RELAXED, __HIP_MEMORY_SCOPE_WORKGROUP);
        __syncthreads();
        if (F.tid < 32 && commit) base[F.tid] = (int)__hip_atomic_fetch_add((unsigned*)(F.ctl + CW_CNT + 64 * F.tid), (unsigned)hist[F.tid], RLX_AGENT);
        __syncthreads();
        if (commit) { const int pos = base[ea] + rank[a], t = blk * 128 + (a >> 2);
          F.rtok[(size_t)ea * CAP + pos] = t; F.rgate[(size_t)ea * CAP + pos] = sel_g[a]; F.tslot[(size_t)t * 4 + (a & 3)] = ((unsigned)ea << 16) | (unsigned)pos; }
        __syncthreads();
    }
}

__device__ __forceinline__ void moe_setup(Frame& F) {
    LAS int* tpre = (LAS int*)(F.aux + A_TPRE); LAS int* cnt = (LAS int*)(F.aux + A_CNT);
    if (F.tid < 32) cnt[F.tid] = (int)__hip_atomic_load((unsigned*)(F.ctl + CW_CNT + 64 * F.tid), RLX_AGENT);
    __syncthreads();
    if (F.tid == 0) { int s = 0; for (int e = 0; e < NE; ++e) { tpre[e] = s; s += (cnt[e] + 255) >> 8; } tpre[NE] = s; }
    __syncthreads();
}

__device__ __forceinline__ void combine_phase(Frame& F, float* dstbase) {
    const LAS int* tpre = (const LAS int*)(F.aux + A_TPRE);
    const int gw = F.vcu * NWAVES + F.wave, NGW = F.G * NWAVES, lane = F.lane;
    for (int t = gw; t < NTOK; t += 2 * NGW) {
        const int t2 = (t + NGW < NTOK) ? t + NGW : t;
        const u32x4 sa = *(const u32x4*)(F.tslot + (size_t)t * 4), sb = *(const u32x4*)(F.tslot + (size_t)t2 * 4);
        f32x4* orow = (f32x4*)(F.out + (size_t)t * DM) + lane; f32x4* orow2 = (f32x4*)(F.out + (size_t)t2 * DM) + lane;
        f32x4 v[4], w[4];
#pragma unroll
        for (int j = 0; j < 4; ++j) { v[j] = orow[64 * j]; w[j] = orow2[64 * j]; }
        u32x2 ya[4][4], yb[4][4];
#pragma unroll
        for (int k = 0; k < 4; ++k) {
            const unsigned s1 = sa[k], s2 = sb[k];
            const u32x2* y1 = (const u32x2*)(F.Y + ((size_t)tpre[s1 >> 16] * 256 + (s1 & 0xffffu)) * DM) + lane;
            const u32x2* y2 = (const u32x2*)(F.Y + ((size_t)tpre[s2 >> 16] * 256 + (s2 & 0xffffu)) * DM) + lane;
#pragma unroll
            for (int j = 0; j < 4; ++j) { ya[k][j] = y1[64 * j]; yb[k][j] = y2[64 * j]; }
        }
#pragma unroll
        for (int k = 0; k < 4; ++k)
#pragma unroll
            for (int j = 0; j < 4; ++j) {
                v[j].x += __uint_as_float(ya[k][j].x << 16); v[j].y += __uint_as_float(ya[k][j].x & 0xffff0000u); v[j].z += __uint_as_float(ya[k][j].y << 16); v[j].w += __uint_as_float(ya[k][j].y & 0xffff0000u);
                w[j].x += __uint_as_float(yb[k][j].x << 16); w[j].y += __uint_as_float(yb[k][j].x & 0xffff0000u); w[j].z += __uint_as_float(yb[k][j].y << 16); w[j].w += __uint_as_float(yb[k][j].y & 0xffff0000u); }
#pragma unroll
        for (int j = 0; j < 4; ++j) ((f32x4*)(dstbase + (size_t)t * DM) + lane)[64 * j] = v[j];
        if (t2 != t) {
#pragma unroll
            for (int j = 0; j < 4; ++j) ((f32x4*)(dstbase + (size_t)t2 * DM) + lane)[64 * j] = w[j]; }
    }
}

struct Args { const float* in[19]; float* out; unsigned char* ws; int ph_lo, ph_hi; };
template <int PLO, int PHI> __global__ void __launch_bounds__(NWAVES * 64, 2) hymba_fwd(Args args) {
    extern __shared__ __attribute__((aligned(16))) unsigned char lds[];
    Frame F;
    F.lds = (LAS unsigned char*)lds; F.aux = F.lds + AUX_OFF;
    F.tid = threadIdx.x; F.lane = F.tid & 63; F.wave = __builtin_amdgcn_readfirstlane(F.tid >> 6);
    F.G = gridDim.x; { const int bx = blockIdx.x; F.vcu = (F.G % 8 == 0) ? (bx % 8) * (F.G / 8) + bx / 8 : bx; }
    unsigned char* ws = args.ws;
    F.ctl = (gu32*)(ws + WS_CTL);
    F.x = args.in[0]; F.meta = args.in[1]; F.g1 = args.in[2]; F.w_in = args.in[3]; F.qg = args.in[4]; F.kg = args.in[5]; F.conv_w = args.in[6]; F.conv_b = args.in[7];
    F.ln_g = args.in[8]; F.ln_b = args.in[9]; F.og = args.in[10]; F.w_out = args.in[11]; F.g2 = args.in[12]; F.w_r = args.in[13]; F.b_r = args.in[14];
    F.w_up = args.in[15]; F.b_up = args.in[16]; F.w_dn = args.in[17]; F.b_dn = args.in[18]; F.out = args.out;
    F.WinT = (bf16*)(ws + WS_WIN); F.WoT = (bf16*)(ws + WS_WO); F.WdT = (bf16*)(ws + WS_WD); F.WupT = (bf16*)(ws + WS_WUP); F.NM = (bf16*)(ws + WS_NM);
    F.Q = (bf16*)(ws + WS_Q); F.Kh = (bf16*)(ws + WS_K); F.VT = (bf16*)(ws + WS_VT); F.HCV = (bf16*)(ws + WS_HCV); F.HN = (bf16*)(ws + WS_HN); F.ACT = (bf16*)(ws + WS_ACT); F.Y = (bf16*)(ws + WS_Y);
    F.rtok = (int*)(ws + WS_RTOK); F.rgate = (float*)(ws + WS_RGATE); F.tslot = (unsigned*)(ws + WS_TSLOT);
    for (int u = F.tid; u < 512 / 4; u += NWAVES * 64) ((LAS unsigned*)(F.lds + LDSCTL_OFF))[u] = 0u;
    __syncthreads();
    XcdBarrier bar; bar.bar = (unsigned*)(F.ctl + CW_BAR); bar.x = 0; bar.st = nullptr;
    if (PHI - PLO > 1) bar = xcd_barrier_post((unsigned*)(F.ctl + CW_BAR), (volatile LAS unsigned*)(F.lds + MISC_OFF) + 8);
    constexpr int lo = PLO, hi = PHI;
#ifndef PH_MASK
#define PH_MASK 0xff
#endif
#define IN(k) (((PH_MASK >> (k)) & 1) && lo <= (k) && (k) < hi)
#define SEAM(k) do { if (IN(k) && IN((k) + 1)) xcd_barrier(bar); } while (0)
    bool moe_ready = false;
#define FRESH() do { int t_ = threadIdx.x; asm volatile("" : "+v"(t_)); F.tid = t_; F.lane = t_ & 63; F.wave = __builtin_amdgcn_readfirstlane(t_ >> 6); } while (0)

    if (IN(0)) { FRESH(); p0_prologue(F); if (NREP(0) > 1) { __syncthreads(); FRESH(); p0_prologue(F); } SEAM(0); }
    if (IN(1)) { FRESH();
        pg8::StaticSched S; S.init(NTOK, INC, DM, F.WinT, F.G, (int)blockIdx.x);
        pg8::EpiIn E{F.Q, F.Kh, F.VT, F.HCV, F.qg, F.kg};
        pg8::gemm_phase(F.lds, (const char*)F.NM, DM, S, E, F.tid); if (NREP(1) > 1) { FRESH(); pg8::gemm_phase(F.lds, (const char*)F.NM, DM, S, E, F.tid); }
        SEAM(1);
    }
    if (IN(2)) { FRESH(); conv_phase(F); if (NREP(2) > 1) { __syncthreads(); FRESH(); conv_phase(F); } __syncthreads(); attn_phase(F); if (NREP(7) > 1) { __syncthreads(); FRESH(); attn_phase(F); } SEAM(2); }
    if (IN(3)) { FRESH();
        pg8::StaticSched S; S.init(NTOK, DM, DM, F.WoT, F.G, (int)blockIdx.x);
        pg8::EpiRes E{F.x, F.out};
        pg8::gemm_phase(F.lds, (const char*)F.NM, DM, S, E, F.tid); if (NREP(3) > 1) { FRESH(); pg8::gemm_phase(F.lds, (const char*)F.NM, DM, S, E, F.tid); }
        SEAM(3);
    }
    if (IN(4)) { FRESH(); if (NREP(4) > 1) { router_phase<(NREP(4) > 1 ? (int)NREP(4) - 2 : 0)>(F, false); __syncthreads(); FRESH(); } router_phase<0>(F, true); SEAM(4); }
    if (IN(5)) { FRESH();
        if (!moe_ready) { moe_setup(F); moe_ready = true; }
        const LAS int* tpre = (const LAS int*)(F.aux + A_TPRE); const LAS int* cnt = (const LAS int*)(F.aux + A_CNT);
        LAS unsigned* idx = (LAS unsigned*)(F.aux + A_IDX);
        pg8::MoeSched<true> S; S.G = F.G; S.v = F.vcu; S.NT = 8; S.ntot = tpre[NE]; S.K2 = 2048u; S.Bt = (const char*)F.WupT; S.bstride = (size_t)2048 * 1024 * 2; S.tpre = tpre; S.idx = idx;
        { pg8::Unit u; for (int i = 0; i < MAXU && S.next(i, u); ++i) { if (F.tid < 256) { const int lr = u.rt * 256 + F.tid; const int tk = (lr < cnt[u.e]) ? F.rtok[(size_t)u.e * CAP + lr] : 0; idx[i * 256 + F.tid] = (unsigned)tk * 2048u; } } }
        __syncthreads();
        pg8::EpiUp E{F.ACT, F.b_up};
        pg8::gemm_phase(F.lds, (const char*)F.HN, DM, S, E, F.tid); if (NREP(5) > 1) { FRESH(); pg8::gemm_phase(F.lds, (const char*)F.HN, DM, S, E, F.tid); }
        SEAM(5);
    }
    if (IN(6)) { FRESH();
        if (!moe_ready) { moe_setup(F); moe_ready = true; }
        const LAS int* tpre = (const LAS int*)(F.aux + A_TPRE);
        pg8::MoeSched<false> S; S.G = F.G; S.v = F.vcu; S.NT = 4; S.ntot = tpre[NE]; S.K2 = 2048u; S.Bt = (const char*)F.WdT; S.bstride = (size_t)1024 * 1024 * 2; S.tpre = tpre; S.idx = nullptr;
        pg8::EpiDown E{F.Y, F.b_dn, F.rgate};
        pg8::gemm_phase(F.lds, (const char*)F.ACT, DE, S, E, F.tid); if (NREP(6) > 1) { FRESH(); pg8::gemm_phase(F.lds, (const char*)F.ACT, DE, S, E, F.tid); }
        SEAM(6);
    }
    if (IN(7)) { FRESH();
        if (!moe_ready) { moe_setup(F); moe_ready = true; }
        if (PROBE_P7) { combine_phase(F, (float*)(ws + WS_ACT)); __syncthreads(); FRESH(); }
        combine_phase(F, F.out);
    }
#undef IN
#undef SEAM
}

template <int PLO, int PHI> static bool launch_range(int& grid, const Args& a, hipStream_t stream) {
    static bool ready = false;
    if (!ready) {
        int dev = 0, cus = 0, per_cu = 0;
        if (hipGetDevice(&dev) != hipSuccess || hipDeviceGetAttribute(&cus, hipDeviceAttributeMultiprocessorCount, dev) != hipSuccess) return false;
        if (hipFuncSetAttribute((const void*)hymba_fwd<PLO, PHI>, hipFuncAttributeMaxDynamicSharedMemorySize, LDS_BYTES) != hipSuccess) { fprintf(stderr, "kernel_launch: hipFuncSetAttribute failed\n"); return false; }
        if (hipOccupancyMaxActiveBlocksPerMultiprocessor(&per_cu, (const void*)hymba_fwd<PLO, PHI>, NWAVES * 64, LDS_BYTES) != hipSuccess || per_cu < 1) fprintf(stderr, "kernel_launch: occupancy query says %d\n", per_cu);
        (void)hipGetLastError();
        grid = cus;
        ready = true;
    }
    hipLaunchKernelGGL((hymba_fwd<PLO, PHI>), dim3(grid), dim3(NWAVES * 64), LDS_BYTES, stream, a);
    return true;
}
extern "C" void kernel_launch(void* const* d_in, const int* in_sizes, int n_in, void* d_out, int out_size, void* d_ws, size_t ws_size, hipStream_t stream) {
    static int grid = 0;
    if (grid < 0) return;
    if (n_in != 19 || in_sizes[0] != NTOK * DM || out_size != NTOK * DM || ws_size < WS_END) { fprintf(stderr, "kernel_launch: unexpected shapes (n_in %d, ws %zu); nothing launched\n", n_in, ws_size); grid = -1; return; }
    if (hipMemsetAsync((char*)d_ws + WS_CTL, 0, CTL_ZERO_BYTES, stream) != hipSuccess) return;
    Args a{};
    for (int i = 0; i < 19; ++i) a.in[i] = (const float*)d_in[i];
    a.out = (float*)d_out; a.ws = (unsigned char*)d_ws; a.ph_lo = 0; a.ph_hi = 8;
#if MK_N_LAUNCHES == 1
    if (!launch_range<0, 8>(grid, a, stream)) grid = -1;
#else
    bool ok = launch_range<0, 1>(grid, a, stream) && launch_range<1, 2>(grid, a, stream) && launch_range<2, 3>(grid, a, stream) && launch_range<3, 4>(grid, a, stream)
           && launch_range<4, 5>(grid, a, stream) && launch_range<5, 6>(grid, a, stream) && launch_range<6, 7>(grid, a, stream) && launch_range<7, 8>(grid, a, stream);
    if (!ok) grid = -1;
#endif
}
```

```cpp
#include <hip/hip_runtime.h>
#include <cstdio>
#include <cstdint>

#ifndef MK_N_LAUNCHES
#define MK_N_LAUNCHES 1
#endif
#ifndef PROBE_REP
#define PROBE_REP 0
#endif
#ifndef PROBE_P7
#define PROBE_P7 0
#endif
#define NREP(k) ((((unsigned)PROBE_REP >> (4 * (k))) & 15u) + 1u)
#ifndef ATTN_EARLY
#define ATTN_EARLY 1
#endif

#define LAS __attribute__((address_space(3)))
#define GAS __attribute__((address_space(1)))
typedef unsigned short bf16;
typedef short bf16x8 __attribute__((ext_vector_type(8)));
typedef float f32x2 __attribute__((ext_vector_type(2)));
typedef float f32x4 __attribute__((ext_vector_type(4)));
typedef float f32x16 __attribute__((ext_vector_type(16)));
typedef unsigned u32x2 __attribute__((ext_vector_type(2)));
typedef unsigned u32x4 __attribute__((ext_vector_type(4)));
typedef GAS unsigned gu32;
typedef int i32x8 __attribute__((ext_vector_type(8)));

constexpr int NB = 8, SEQ = 4096, DM = 1024, NTOK = NB * SEQ;
constexpr int NMETA = 16, LPAD = 16, LP = LPAD + NMETA + SEQ;
constexpr int NH = 8, HD = 64, SBW = 512, CW = 512, CKW = 31, INC = 2560;
constexpr int NE = 32, TOPK = 4, DE = 1024, CAP = NTOK;
constexpr int MAXROWS = NTOK * TOPK + NE * 256;
constexpr float EPS = 1e-6f;
constexpr float LOG2E = 1.4426950408889634f;
constexpr float QSCALE = 0.125f * LOG2E;
constexpr float SW_LIMIT = 7.0f, SW_ALPHA = 1.702f;
constexpr float ATTN_CUT = 1e-30f;
constexpr float SC_W = 128.0f, SC_HN = 8.0f, SC_ACT = 4.0f, F8_MAX = 448.0f;

constexpr size_t MiB = 1u << 20;
constexpr size_t WS_CTL = 0, CTL_ZERO_BYTES = 1 * MiB;
constexpr size_t WS_WIN = 1 * MiB, WS_WO = 6 * MiB, WS_WD = 8 * MiB, WS_WUP = 72 * MiB;
constexpr size_t WS_NM = 200 * MiB;
constexpr size_t WS_Q = 264 * MiB, WS_K = 296 * MiB, WS_VT = 329 * MiB, WS_HCV = 362 * MiB;
constexpr size_t WS_ACT = 395 * MiB;
constexpr size_t WS_RTOK = 667 * MiB, WS_RGATE = 671 * MiB, WS_TSLOT = 675 * MiB, WS_END = 676 * MiB;
constexpr size_t WS_HN = WS_Q;
constexpr size_t WS_Y = WS_WUP;
static_assert(WS_Y + (size_t)MAXROWS * 2048 <= WS_HCV && WS_ACT + (size_t)MAXROWS * 2048 <= WS_RTOK, "ws map");
constexpr int CW_TMO = 0, CW_BAR = 4096, CW_CNT = 8192;

constexpr int RING_BYTES = 131072;
constexpr int LDSCTL_OFF = RING_BYTES, MISC_OFF = LDSCTL_OFF + 320, AUX_OFF = LDSCTL_OFF + 512;
constexpr int A_TPRE = 0, A_CNT = 256, A_HIST = 384, A_BASE = 512, A_RED = 640, A_TOT = 1664, A_SELE = 1792, A_SELG = 3840, A_RANK = 5888, A_IDX = 8192;
constexpr int MAXU = 17;
constexpr int LDS_BYTES = AUX_OFF + A_IDX + MAXU * 1024;
static_assert(LDS_BYTES <= 163840, "LDS");
constexpr int NWAVES = 8;

#define LDS_WAIT() asm volatile("s_waitcnt lgkmcnt(0)" ::: "memory")
#define VM_WAIT() asm volatile("s_waitcnt vmcnt(0)" ::: "memory")
#define RLX_AGENT __ATOMIC_RELAXED, __HIP_MEMORY_SCOPE_AGENT

__device__ __forceinline__ unsigned cvt_pk_bf16(float lo, float hi) { unsigned r; asm volatile("v_cvt_pk_bf16_f32 %0, %1, %2" : "=v"(r) : "v"(lo), "v"(hi)); return r; }
__device__ __forceinline__ float bf2f(bf16 b) { return __uint_as_float(((unsigned)b) << 16); }
__device__ __forceinline__ bf16 f2bf(float f) { return (bf16)(cvt_pk_bf16(f, 0.f) & 0xffffu); }
__device__ __forceinline__ unsigned pack4_fp8(float a, float b, float c, float d) {
    a = __builtin_amdgcn_fmed3f(a, -F8_MAX, F8_MAX); b = __builtin_amdgcn_fmed3f(b, -F8_MAX, F8_MAX); c = __builtin_amdgcn_fmed3f(c, -F8_MAX, F8_MAX); d = __builtin_amdgcn_fmed3f(d, -F8_MAX, F8_MAX);
    int p = __builtin_amdgcn_cvt_pk_fp8_f32(a, b, 0, false); p = __builtin_amdgcn_cvt_pk_fp8_f32(c, d, p, true); return (unsigned)p;
}
__device__ __forceinline__ float fast_rcp(float x) { return __builtin_amdgcn_rcpf(x); }
__device__ __forceinline__ float fast_exp2(float x) { return __builtin_amdgcn_exp2f(x); }
__device__ __forceinline__ float sigmoidf_(float x) { return fast_rcp(1.0f + fast_exp2(-x * LOG2E)); }
template <int CTRL> __device__ __forceinline__ float dpp_f(float v) { return __builtin_bit_cast(float, __builtin_amdgcn_update_dpp(0, __builtin_bit_cast(int, v), CTRL, 0xf, 0xf, true)); }
template <int CTRL> __device__ __forceinline__ int dpp_i(int v) { return __builtin_amdgcn_update_dpp(0, v, CTRL, 0xf, 0xf, true); }
#define DPP_ROW_MIRROR 0x140
#define DPP_ROW_HALF_MIRROR 0x141
#define DPP_QUAD_REV 0x1B
#define DPP_QUAD_SWAP 0xB1
__device__ __forceinline__ float row_allsum(float v) {
    v += dpp_f<DPP_ROW_MIRROR>(v); v += dpp_f<DPP_ROW_HALF_MIRROR>(v); v += dpp_f<DPP_QUAD_REV>(v); v += dpp_f<DPP_QUAD_SWAP>(v); return v;
}
__device__ __forceinline__ float swap16_sum(float a, float b) {
    const auto r = __builtin_amdgcn_permlane16_swap(__float_as_uint(a), __float_as_uint(b), false, false); return __uint_as_float(r[0]) + __uint_as_float(r[1]);
}
__device__ __forceinline__ float swap32_sum(float a, float b) {
    const auto r = __builtin_amdgcn_permlane32_swap(__float_as_uint(a), __float_as_uint(b), false, false); return __uint_as_float(r[0]) + __uint_as_float(r[1]);
}
__device__ __forceinline__ float wave_sum(float v) { v = row_allsum(v); v = swap16_sum(v, v); return swap32_sum(v, v); }
__device__ __forceinline__ void wave_reduce32(float (&v)[32]) {
#pragma unroll
    for (int i = 0; i < 16; ++i) v[i] = swap32_sum(v[i], v[i + 16]);
#pragma unroll
    for (int i = 0; i < 8; ++i) v[i] = swap16_sum(v[i], v[i + 8]);
#pragma unroll
    for (int i = 0; i < 8; ++i) v[i] = row_allsum(v[i]);
}
#define XB_TMO      128
#define XB_XCNT(j)  (256  + 64 * (j))
#define XB_XSUB(j)  (1280 + 64 * (j))
#define XB_XGEN(j)  (2304 + 64 * (j))
#define XB_TOP      3328
#define XB_TOPGEN   3392
#define XCD_BAR_WORDS 3456
#define XB_SPIN_CAP (1u << 18)
__device__ __forceinline__ unsigned xb_ld(unsigned* p)              { return __hip_atomic_load(p, __ATOMIC_RELAXED, __HIP_MEMORY_SCOPE_AGENT); }
__device__ __forceinline__ unsigned xb_add(unsigned* p, unsigned v) { return __hip_atomic_fetch_add(p, v, __ATOMIC_RELAXED, __HIP_MEMORY_SCOPE_AGENT); }
__device__ __forceinline__ unsigned xb_xcc_id() { return (unsigned)__builtin_amdgcn_s_getreg((3 << 11) | 20) & 0xFu; }
#define XB_SPIN(cond, bar) do { unsigned _sp = 0; while (cond) { __builtin_amdgcn_s_sleep(1); \
    if ((++_sp & 255u) == 0u) { if (xb_ld(&(bar)[XB_TMO])) break; if (_sp > XB_SPIN_CAP) { atomicAdd(&(bar)[XB_TMO], 1u); break; } } } } while (0)
struct XcdBarrier { unsigned* bar; unsigned x; volatile LAS unsigned* st; };
__device__ __forceinline__ XcdBarrier xcd_barrier_post(unsigned* bar, volatile LAS unsigned* st) {
    XcdBarrier b; b.bar = bar; b.x = xb_xcc_id(); b.st = st;
    if (threadIdx.x == 0) (void)xb_add(&bar[XB_XCNT(b.x)], 1u);
    return b;
}
__device__ __forceinline__ void xcd_barrier_complete(unsigned* bar, unsigned x, unsigned& nloc, unsigned& nx) {
    const unsigned G = gridDim.x * gridDim.y * gridDim.z;
    unsigned sum, cnt, mine, sp = 0u;
    for (;;) {
        sum = 0u; cnt = 0u; mine = 0u;
#pragma unroll
        for (unsigned j = 0; j < 16; ++j) { const unsigned c = xb_ld(&bar[XB_XCNT(j)]); sum += c; cnt += (c > 0u) ? 1u : 0u; mine = (j == x) ? c : mine; }
        if (sum == G) break;
        __builtin_amdgcn_s_sleep(1);
        if ((++sp & 255u) == 0u) { if (xb_ld(&bar[XB_TMO])) break; if (sp > XB_SPIN_CAP) { atomicAdd(&bar[XB_TMO], 1u); break; } }
    }
    nloc = mine > 0u ? mine : 1u; nx = cnt > 0u ? cnt : 1u;
}
__device__ __forceinline__ void xcd_barrier(const XcdBarrier& b) {
    asm volatile("s_waitcnt vmcnt(0)" ::: "memory");
    __syncthreads();
    if (threadIdx.x == 0) {
        unsigned* bar = b.bar;
        __builtin_amdgcn_s_waitcnt(0);
        unsigned nloc = b.st[0], nx = b.st[1];
        if (nloc == 0u) { xcd_barrier_complete(bar, b.x, nloc, nx); b.st[0] = nloc; b.st[1] = nx; }
        const unsigned old = xb_add(&bar[XB_XSUB(b.x)], 1u);
        const unsigned gen = old / nloc;
        if (old + 1u == (gen + 1u) * nloc) {
            __builtin_amdgcn_fence(__ATOMIC_RELEASE, "agent");
            asm volatile("s_waitcnt vmcnt(0)" ::: "memory");
            const unsigned og = xb_add(&bar[XB_TOP], 1u);
            const unsigned tg = og / nx;
            if (og + 1u == (tg + 1u) * nx) xb_add(&bar[XB_TOPGEN], 1u);
            else XB_SPIN(xb_ld(&bar[XB_TOPGEN]) == tg, bar);
            __builtin_amdgcn_fence(__ATOMIC_ACQUIRE, "agent");
            xb_add(&bar[XB_XGEN(b.x)], 1u);
            asm volatile("s_waitcnt vmcnt(0)" ::: "memory");
        } else {
            XB_SPIN(xb_ld(&bar[XB_XGEN(b.x)]) == gen, bar);
            __builtin_amdgcn_fence(__ATOMIC_ACQUIRE, "agent");
            asm volatile("s_waitcnt vmcnt(0)" ::: "memory");
        }
    }
    __syncthreads();
}

namespace pg8 {
constexpr int BM = 256, BK = 64, HALF = 128, HTB = HALF * BK * 2, STAGE_BYTES = 8 * HTB, NXCD = 8, WGM = 8;
__device__ __forceinline__ int lds_byte(int r, int c) { const int st = (r >> 4) * 2 + (c >> 5), rr = r & 15, cc = c & 31, ob = rr * 64 + cc * 2; return st * 1024 + (ob ^ (((ob >> 9) & 1) << 5)); }
__device__ __forceinline__ void stage_rc(int b, int& R, int& C) { const int st = b / 1024, sb = b % 1024, swz = sb ^ (((sb >> 9) & 1) << 5); R = (st >> 1) * 16 + swz / 64; C = (st & 1) * 32 + (swz % 64) / 2; }
__device__ __forceinline__ int perm32(int rho) { const int n = rho >> 4, i = rho & 15; return 8 * (i >> 2) + 4 * n + (i & 3); }

struct Unit { int pm, pn, e, rt; };

struct StaticSched {
    int nM, nN, nwg, G, c; unsigned K2; const char* Bt;
    __device__ void init(int M, int N, int K, const void* Bt_, int G_, int c_) { nM = M / BM; nN = N / BM; nwg = nM * nN; G = G_; c = c_; K2 = (unsigned)K * 2u; Bt = (const char*)Bt_; }
    __device__ __forceinline__ bool next(int i, Unit& u) const {
        const long L = (long)i * G + c; if (L >= nwg) return false;
        int wgid = (int)L; { const int q = nwg / NXCD, r = nwg % NXCD, xcd = wgid % NXCD, off = wgid / NXCD; wgid = (xcd < r ? xcd * (q + 1) : r * (q + 1) + (xcd - r) * q) + off; }
        const int nig = WGM * nN, gid = wgid / nig, fm = gid * WGM, gsz = (nM - fm) < WGM ? (nM - fm) : WGM;
        u.pm = fm + ((wgid % nig) % gsz); u.pn = (wgid % nig) / gsz; u.e = 0; u.rt = 0; return true;
    }
    __device__ __forceinline__ unsigned aoff(int, const Unit& u, int row) const { return (unsigned)(u.pm * BM + row) * K2; }
    __device__ __forceinline__ const char* bbase() const { return Bt; }
    __device__ __forceinline__ unsigned boff(const Unit& u) const { return (unsigned)(u.pn * BM) * K2; }
};
template <bool GATHER> struct MoeSched {
    int G, v, NT, ntot; unsigned K2; const char* Bt; size_t bstride; const LAS int* tpre; const LAS unsigned* idx;
    __device__ __forceinline__ bool next(int i, Unit& u) const {
        const int U = i * G + v; if (U >= ntot * NT) return false;
        const int rtg = U / NT; u.pm = rtg; u.pn = U - rtg * NT;
        int lo = 0, hi = NE;
#pragma unroll
        for (int s = 0; s < 5; ++s) { const int mid = (lo + hi) >> 1; const int t = __builtin_amdgcn_readfirstlane(tpre[mid]); if (rtg >= t) lo = mid; else hi = mid; }
        u.e = lo; u.rt = rtg - __builtin_amdgcn_readfirstlane(tpre[lo]); return true;
    }
    __device__ __forceinline__ unsigned aoff(int i, const Unit& u, int row) const { if (GATHER) return idx[i * 256 + row]; return (unsigned)(u.pm * BM + row) * K2; }
    __device__ __forceinline__ const char* bbase() const { return Bt; }
    __device__ __forceinline__ unsigned boff(const Unit& u) const { return (unsigned)u.e * (unsigned)bstride + (unsigned)(u.pn * BM) * K2; }
};

template <class Epi, class Sched>
__device__ __forceinline__ void gemm_phase(LAS unsigned char* lds, const char* Abase, const int KB  , const Sched& S, const Epi& E, const int tid) {
    const int wid = __builtin_amdgcn_readfirstlane(tid >> 6), lane = tid & 63, wr = wid >> 2, wc = wid & 3, fr = lane & 15, fq = lane >> 4;
    const int nt = KB / 128;
    int Rr[2]; unsigned colA[2], voffB[2];
#pragma unroll
    for (int i = 0; i < 2; ++i) { int R, C; stage_rc(tid * 16 + i * 8192, R, C); const int Rb = Epi::PERM ? ((R & ~31) + perm32(R & 31)) : R;
        Rr[i] = R; colA[i] = (unsigned)C * 2u; voffB[i] = (unsigned)(Rb * KB + C * 2); }
    const unsigned kstep = (unsigned)(BK * 2);
    const unsigned hstep = (unsigned)HALF * (unsigned)KB;
    const unsigned ldsw = (unsigned)wid * 1024u;
    const int aoff = lds_byte(wr * 64 + fr, fq * 8), boff = lds_byte(wc * 32 + fr, fq * 8);
    const __amdgpu_buffer_rsrc_t rA = __builtin_amdgcn_make_buffer_rsrc((void*)Abase, 0, 0xffffffff, 0x00020000);
    const __amdgpu_buffer_rsrc_t rB = __builtin_amdgcn_make_buffer_rsrc((void*)S.bbase(), 0, 0xffffffff, 0x00020000);
#define PG8_SA(b, h) (((b) * 2 + (h)) * HTB)
#define PG8_SB(b, h) ((4 + (b) * 2 + (h)) * HTB)
#define PG8_STAGEB(bufoff, soff) do { _Pragma("unroll") for (int _i = 0; _i < 2; ++_i) \
        __builtin_amdgcn_raw_ptr_buffer_load_lds(rB, (LAS unsigned*)(lds + (bufoff) + ldsw + _i * 8192), 16, voffB[_i], (soff), 0, 0); } while (0)
#define PG8_STAGEA(bufoff, offs, soff) do { _Pragma("unroll") for (int _i = 0; _i < 2; ++_i) \
        __builtin_amdgcn_raw_ptr_buffer_load_lds(rA, (LAS unsigned*)(lds + (bufoff) + ldsw + _i * 8192), 16, (offs)[_i], (soff), 0, 0); } while (0)
#define PG8_LDA(dst, b, h) do { _Pragma("unroll") for (int m = 0; m < 4; ++m) _Pragma("unroll") for (int k = 0; k < 2; ++k) dst[m][k] = *(const LAS bf16x8*)(lds + PG8_SA(b, h) + aoff + m * 2048 + k * 1024); } while (0)
#define PG8_LDB(dst, b, h) do { _Pragma("unroll") for (int n = 0; n < 2; ++n) _Pragma("unroll") for (int k = 0; k < 2; ++k) dst[n][k] = *(const LAS bf16x8*)(lds + PG8_SB(b, h) + boff + n * 2048 + k * 1024); } while (0)
#define PG8_CAT(x) __builtin_shufflevector(__builtin_bit_cast(u32x4, (x)[0]), __builtin_bit_cast(u32x4, (x)[1]), 0, 1, 2, 3, 4, 5, 6, 7)
#define PG8_MMA(ai, bj, At, Bt) do { __builtin_amdgcn_s_setprio(1); \
        if constexpr (Epi::FP8) { _Pragma("unroll") for (int m = 0; m < 4; ++m) _Pragma("unroll") for (int n = 0; n < 2; ++n) \
            { const i32x8 b8_ = __builtin_bit_cast(i32x8, PG8_CAT(Bt[n])), a8_ = __builtin_bit_cast(i32x8, PG8_CAT(At[m])); \
              asm volatile("v_mfma_f32_16x16x128_f8f6f4 %0, %1, %2, %0" : "+v"(acc[ai][bj][m][n]) : "v"(b8_), "v"(a8_)); } } \
        else { _Pragma("unroll") for (int m = 0; m < 4; ++m) _Pragma("unroll") for (int n = 0; n < 2; ++n) _Pragma("unroll") for (int k = 0; k < 2; ++k) \
            acc[ai][bj][m][n] = __builtin_amdgcn_mfma_f32_16x16x32_bf16(Bt[n][k], At[m][k], acc[ai][bj][m][n], 0, 0, 0); } \
        __builtin_amdgcn_s_setprio(0); } while (0)
#define PG8_WAIT_V(n) asm volatile("s_waitcnt vmcnt(" #n ")" ::: "memory")
#define PG8_WAIT_L(n) asm volatile("s_waitcnt lgkmcnt(" #n ")" ::: "memory")
#define PG8_BAR __builtin_amdgcn_s_barrier()
#define PG8_SCHED __builtin_amdgcn_sched_barrier(0)
#define PG8_KPAIR(K1, A20, A21, KA2, B2) do { \
            PG8_LDB(B0, 0, 0); PG8_LDB(B1, 0, 1); PG8_SCHED; PG8_LDA(At, 0, 0); PG8_STAGEA(PG8_SA(1, 1), ca1, (K1)); \
            PG8_WAIT_V(8); PG8_WAIT_L(0); PG8_BAR; PG8_MMA(0, 0, At, B0); PG8_MMA(0, 1, At, B1); PG8_BAR; PG8_SCHED; \
            PG8_LDA(At, 0, 1); PG8_STAGEB(PG8_SB(0, 0), (B2)); PG8_STAGEB(PG8_SB(0, 1), (B2) + hstep); PG8_STAGEA(PG8_SA(0, 0), A20, (KA2)); \
            PG8_WAIT_V(8); PG8_WAIT_L(0); PG8_BAR; PG8_MMA(1, 0, At, B0); PG8_MMA(1, 1, At, B1); PG8_BAR; PG8_SCHED; \
            PG8_LDB(B0, 1, 0); PG8_LDB(B1, 1, 1); PG8_SCHED; PG8_LDA(At, 1, 0); PG8_STAGEA(PG8_SA(0, 1), A21, (KA2)); \
            PG8_WAIT_V(8); PG8_WAIT_L(0); PG8_BAR; PG8_MMA(0, 0, At, B0); PG8_MMA(0, 1, At, B1); PG8_BAR; PG8_SCHED; \
            PG8_LDA(At, 1, 1); PG8_STAGEB(PG8_SB(1, 0), (B2) + kstep); PG8_STAGEB(PG8_SB(1, 1), (B2) + kstep + hstep); PG8_STAGEA(PG8_SA(1, 0), A20, (KA2) + kstep); \
            PG8_WAIT_V(8); PG8_WAIT_L(0); PG8_BAR; PG8_MMA(1, 0, At, B0); PG8_MMA(1, 1, At, B1); PG8_BAR; PG8_SCHED; } while (0)
    Unit cur, nxt; int ui = 0;
    if (!S.next(0, cur)) return;
    f32x4 acc[2][2][4][2];
#pragma unroll
    for (int a = 0; a < 2; ++a)
#pragma unroll
        for (int b = 0; b < 2; ++b)
#pragma unroll
            for (int m = 0; m < 4; ++m)
#pragma unroll
                for (int n = 0; n < 2; ++n) acc[a][b][m][n] = (f32x4){0.f, 0.f, 0.f, 0.f};
    bf16x8 At[4][2], B0[2][2], B1[2][2];
    unsigned ca0[2], ca1[2], na0[2], na1[2];
#pragma unroll
    for (int i = 0; i < 2; ++i) { ca0[i] = S.aoff(0, cur, Rr[i]) + colA[i]; ca1[i] = S.aoff(0, cur, HALF + Rr[i]) + colA[i]; }
    unsigned cB = S.boff(cur);
    PG8_STAGEB(PG8_SB(0, 0), cB); PG8_STAGEB(PG8_SB(0, 1), cB + hstep); PG8_STAGEA(PG8_SA(0, 0), ca0, 0u); PG8_STAGEA(PG8_SA(0, 1), ca1, 0u);
    if (wr == 1) PG8_BAR;
    PG8_WAIT_V(2); PG8_BAR;
    PG8_STAGEB(PG8_SB(1, 0), cB + kstep); PG8_STAGEA(PG8_SA(1, 0), ca0, kstep); PG8_STAGEB(PG8_SB(1, 1), cB + hstep + kstep);
    PG8_WAIT_V(6); PG8_BAR;
    for (;;) {
        const bool has_next = S.next(ui + 1, nxt);
        const unsigned nB = has_next ? S.boff(nxt) : cB;
#pragma unroll
        for (int i = 0; i < 2; ++i) { na0[i] = has_next ? S.aoff(ui + 1, nxt, Rr[i]) + colA[i] : ca0[i]; na1[i] = has_next ? S.aoff(ui + 1, nxt, HALF + Rr[i]) + colA[i] : ca1[i]; }
#pragma unroll 1
        for (int t = 0; t < nt - 2; t += 2) { const unsigned k1 = (unsigned)(t + 1) * kstep, k2 = (unsigned)(t + 2) * kstep; PG8_KPAIR(k1, ca0, ca1, k2, cB + k2); }
        { const unsigned k1 = (unsigned)(nt - 1) * kstep; PG8_KPAIR(k1, na0, na1, 0u, nB); }
        if (wr == 0) PG8_BAR;
        if constexpr (Epi::FP8) asm volatile("s_nop 15\n\ts_nop 7" ::: "memory");
        E(acc, cur, wr, wc, fr, fq);
        if (!has_next) break;
#pragma unroll
        for (int a = 0; a < 2; ++a)
#pragma unroll
            for (int b = 0; b < 2; ++b)
#pragma unroll
                for (int m = 0; m < 4; ++m)
#pragma unroll
                    for (int n = 0; n < 2; ++n) acc[a][b][m][n] = (f32x4){0.f, 0.f, 0.f, 0.f};
        cur = nxt; cB = nB; ++ui;
#pragma unroll
        for (int i = 0; i < 2; ++i) { ca0[i] = na0[i]; ca1[i] = na1[i]; }
        if (wr == 1) PG8_BAR;
    }
    PG8_WAIT_V(0);
    PG8_BAR;
#undef PG8_KPAIR
#undef PG8_CAT
#undef PG8_SA
#undef PG8_SB
#undef PG8_STAGEA
#undef PG8_STAGEB
#undef PG8_LDA
#undef PG8_LDB
#undef PG8_MMA
#undef PG8_WAIT_V
#undef PG8_WAIT_L
#undef PG8_BAR
#undef PG8_SCHED
}

struct EpiIn {
    static constexpr bool PERM = true, FP8 = false;
    bf16 *Q, *Kh, *VT, *HCV; const float *qg, *kg;
    __device__ __forceinline__ void operator()(const f32x4 (&acc)[2][2][4][2], const Unit& u, int wr, int wc, int fr, int fq) const {
        const int pn = u.pn;
        const int row0 = u.pm * BM + wr * 64 + fr;
        if (pn < 4) {
            const bool isq = pn < 2; const float* g = isq ? qg : kg; const float sc = isq ? QSCALE : 1.0f;
            const int head = 4 * (pn & 1) + wc;
            f32x4 gv[2][2];
#pragma unroll
            for (int bj = 0; bj < 2; ++bj)
#pragma unroll
                for (int n = 0; n < 2; ++n) gv[bj][n] = *(const f32x4*)(g + 32 * bj + 8 * fq + 4 * n) * sc;
#pragma unroll
            for (int ai = 0; ai < 2; ++ai)
#pragma unroll
                for (int m = 0; m < 4; ++m) {
                    float ss = 0.f;
#pragma unroll
                    for (int bj = 0; bj < 2; ++bj)
#pragma unroll
                        for (int n = 0; n < 2; ++n) { const f32x4 x = acc[ai][bj][m][n]; ss += (x[0] * x[0] + x[1] * x[1]) + (x[2] * x[2] + x[3] * x[3]); }
                    ss += __shfl_xor(ss, 16); ss += __shfl_xor(ss, 32);
                    const float rs = __builtin_amdgcn_rsqf(ss * (1.0f / 64.0f) + EPS);
                    const int row = row0 + ai * HALF + m * 16, b = row >> 12, t = row & 4095;
                    bf16* dst = isq ? Q + ((size_t)(b * NH + head) * SEQ + t) * HD : Kh + ((size_t)(b * NH + head) * LP + 32 + t) * HD;
#pragma unroll
                    for (int bj = 0; bj < 2; ++bj) { const f32x4 v0 = acc[ai][bj][m][0] * rs * gv[bj][0], v1 = acc[ai][bj][m][1] * rs * gv[bj][1];
                        u32x4 w; w.x = cvt_pk_bf16(v0[0], v0[1]); w.y = cvt_pk_bf16(v0[2], v0[3]); w.z = cvt_pk_bf16(v1[0], v1[1]); w.w = cvt_pk_bf16(v1[2], v1[3]);
                        *(u32x4*)(dst + 32 * bj + 8 * fq) = w; }
                }
        } else if (pn < 6) {
            const int head = 4 * (pn & 1) + wc;
#pragma unroll
            for (int ai = 0; ai < 2; ++ai)
#pragma unroll
                for (int m = 0; m < 4; ++m) {
                    const int row = row0 + ai * HALF + m * 16, b = row >> 12, t = row & 4095;
                    bf16* dst = VT + ((size_t)(b * NH + head) * HD) * LP + 32 + t;
#pragma unroll
                    for (int bj = 0; bj < 2; ++bj)
#pragma unroll
                        for (int n = 0; n < 2; ++n)
#pragma unroll
                            for (int e = 0; e < 4; ++e) dst[(size_t)(32 * bj + 8 * fq + 4 * n + e) * LP] = f2bf(acc[ai][bj][m][n][e]);
                }
        } else {
            const int ch0 = 128 * (pn - 6) + 32 * wc + 8 * fq;
#pragma unroll
            for (int ai = 0; ai < 2; ++ai)
#pragma unroll
                for (int m = 0; m < 4; ++m) {
                    const int row = row0 + ai * HALF + m * 16, b = row >> 12, t = row & 4095;
                    f32x4 h0, h1;
#pragma unroll
                    for (int e = 0; e < 4; ++e) { h0[e] = acc[ai][0][m][0][e] * sigmoidf_(acc[ai][1][m][0][e]); h1[e] = acc[ai][0][m][1][e] * sigmoidf_(acc[ai][1][m][1][e]); }
                    u32x4 w; w.x = cvt_pk_bf16(h0[0], h0[1]); w.y = cvt_pk_bf16(h0[2], h0[3]); w.z = cvt_pk_bf16(h1[0], h1[1]); w.w = cvt_pk_bf16(h1[2], h1[3]);
                    *(u32x4*)(HCV + ((size_t)b * LP + 32 + t) * CW + ch0) = w;
                }
        }
    }
};
struct EpiRes {
    static constexpr bool PERM = false, FP8 = false;
    const float* X; float* O;
    __device__ __forceinline__ void operator()(const f32x4 (&acc)[2][2][4][2], const Unit& u, int wr, int wc, int fr, int fq) const {
        const int row0 = u.pm * BM + wr * 64 + fr, col0 = u.pn * BM + wc * 32 + 4 * fq;
#pragma unroll
        for (int ai = 0; ai < 2; ++ai)
#pragma unroll
            for (int m = 0; m < 4; ++m) { const size_t off = (size_t)(row0 + ai * HALF + m * 16) * DM + col0;
#pragma unroll
                for (int bj = 0; bj < 2; ++bj)
#pragma unroll
                    for (int n = 0; n < 2; ++n) { const f32x4 xv = *(const f32x4*)(X + off + bj * HALF + n * 16); *(f32x4*)(O + off + bj * HALF + n * 16) = xv + acc[ai][bj][m][n]; } }
    }
};
struct EpiUp {
    static constexpr bool PERM = true, FP8 = true;
    unsigned char* ACT; const float* bup;
    __device__ __forceinline__ void operator()(const f32x4 (&acc)[2][2][4][2], const Unit& u, int wr, int wc, int fr, int fq) const {
        const int c0 = 128 * u.pn + 32 * wc + 8 * fq;
        const float* bb = bup + (size_t)u.e * 2048 + c0;
        const f32x4 bg0 = *(const f32x4*)(bb), bg1 = *(const f32x4*)(bb + 4), bl0 = *(const f32x4*)(bb + 1024), bl1 = *(const f32x4*)(bb + 1028);
        const int row0 = u.pm * BM + wr * 64 + fr;
#pragma unroll
        for (int ai = 0; ai < 2; ++ai)
#pragma unroll
            for (int m = 0; m < 4; ++m) {
                constexpr float dq = 1.0f / (SC_HN * SC_W);
                const f32x4 g0 = acc[ai][0][m][0] * dq + bg0, g1 = acc[ai][0][m][1] * dq + bg1, l0 = acc[ai][1][m][0] * dq + bl0, l1 = acc[ai][1][m][1] * dq + bl1;
                f32x4 a0, a1;
#pragma unroll
                for (int e = 0; e < 4; ++e) {
                    const float ga = fminf(g0[e], SW_LIMIT), la = fminf(fmaxf(l0[e], -SW_LIMIT), SW_LIMIT); a0[e] = ga * sigmoidf_(SW_ALPHA * ga) * (la + 1.0f);
                    const float gb = fminf(g1[e], SW_LIMIT), lb = fminf(fmaxf(l1[e], -SW_LIMIT), SW_LIMIT); a1[e] = gb * sigmoidf_(SW_ALPHA * gb) * (lb + 1.0f); }
                u32x2 w; w.x = pack4_fp8(a0[0] * SC_ACT, a0[1] * SC_ACT, a0[2] * SC_ACT, a0[3] * SC_ACT); w.y = pack4_fp8(a1[0] * SC_ACT, a1[1] * SC_ACT, a1[2] * SC_ACT, a1[3] * SC_ACT);
                *(u32x2*)(ACT + (size_t)(row0 + ai * HALF + m * 16) * DE + c0) = w;
            }
    }
};
struct EpiDown {
    static constexpr bool PERM = true, FP8 = true;
    bf16* Y; const float* bdn; const float* rgate;
    __device__ __forceinline__ void operator()(const f32x4 (&acc)[2][2][4][2], const Unit& u, int wr, int wc, int fr, int fq) const {
        const int c0 = u.pn * BM + wc * 32 + 8 * fq;
        const float* bb = bdn + (size_t)u.e * DM + c0;
        f32x4 bv[2][2];
#pragma unroll
        for (int bj = 0; bj < 2; ++bj)
#pragma unroll
            for (int n = 0; n < 2; ++n) bv[bj][n] = *(const f32x4*)(bb + bj * HALF + 4 * n);
        const int lrow0 = wr * 64 + fr;
        const float* gp = rgate + (size_t)u.e * CAP + u.rt * BM;
#pragma unroll
        for (int ai = 0; ai < 2; ++ai)
#pragma unroll
            for (int m = 0; m < 4; ++m) {
                const int lr = lrow0 + ai * HALF + m * 16; const float gt = gp[lr];
                bf16* rowp = Y + (size_t)(u.pm * BM + lr) * DM + c0;
#pragma unroll
                for (int bj = 0; bj < 2; ++bj) { constexpr float dq = 1.0f / (SC_ACT * SC_W); const f32x4 v0 = (acc[ai][bj][m][0] * dq + bv[bj][0]) * gt, v1 = (acc[ai][bj][m][1] * dq + bv[bj][1]) * gt;
                    u32x4 w; w.x = cvt_pk_bf16(v0[0], v0[1]); w.y = cvt_pk_bf16(v0[2], v0[3]); w.z = cvt_pk_bf16(v1[0], v1[1]); w.w = cvt_pk_bf16(v1[2], v1[3]);
                    *(u32x4*)(rowp + bj * HALF) = w; }
            }
    }
};
}

struct Frame {
    LAS unsigned char* lds; LAS unsigned char* aux;
    gu32* ctl;
    int tid, lane, wave, vcu, G;
    const float *x, *meta, *g1, *w_in, *qg, *kg, *conv_w, *conv_b, *ln_g, *ln_b, *og, *w_out, *g2, *w_r, *b_r, *w_up, *b_up, *w_dn, *b_dn;
    float* out;
    bf16 *WinT, *WoT, *NM, *Q, *Kh, *VT, *HCV, *Y;
    unsigned char *WdT, *WupT, *HN, *ACT;
    int* rtok; float* rgate; unsigned* tslot;
};

__device__ __forceinline__ int win_dest(int n0) {
    if (n0 < 1536) { const int tile = n0 >> 8, s = n0 & 255, wc = s >> 6, bj = (s >> 5) & 1; return tile * 256 + 128 * bj + 32 * wc; }
    if (n0 < 2048) { const int j = n0 - 1536; return 1536 + 256 * (j >> 7) + (j & 127); }
    const int j = n0 - 2048; return 1536 + 256 * (j >> 7) + 128 + (j & 127);
}
__device__ __forceinline__ int wup_dest(int n0) { if (n0 < 1024) return 256 * (n0 >> 7) + (n0 & 127); const int j = n0 - 1024; return 256 * (j >> 7) + 128 + (j & 127); }
struct TrItem { const float* src; const float* g; void* dst; int N; int f8; };
__device__ __forceinline__ void tr_load(const TrItem& t, f32x4 (&v)[8], float (&gv)[8], int lane) {
    const int kr = lane >> 3, nc = (lane & 7) * 4;
#pragma unroll
    for (int i = 0; i < 8; ++i) { v[i] = *(const f32x4*)(t.src + (size_t)(8 * i + kr) * t.N + nc); gv[i] = t.g ? t.g[8 * i + kr] : 1.0f; }
}
__device__ __forceinline__ void tr_store(const TrItem& t, const f32x4 (&v)[8], const float (&gv)[8], LAS float* scr, int lane) {
    const int kr = lane >> 3, nc = (lane & 7) * 4;
#pragma unroll
    for (int i = 0; i < 8; ++i) { LAS float* d = scr + (8 * i + kr) * 33 + nc; d[0] = v[i].x * gv[i]; d[1] = v[i].y * gv[i]; d[2] = v[i].z * gv[i]; d[3] = v[i].w * gv[i]; }
    LDS_WAIT(); asm volatile("" ::: "memory");
    const int c = lane & 7;
#pragma unroll
    for (int j = 0; j < 4; ++j) { const int n = (lane >> 3) + 8 * j; const LAS float* q = scr + (8 * c) * 33 + n;
        if (t.f8) { u32x2 o; o.x = pack4_fp8(q[0 * 33] * SC_W, q[1 * 33] * SC_W, q[2 * 33] * SC_W, q[3 * 33] * SC_W); o.y = pack4_fp8(q[4 * 33] * SC_W, q[5 * 33] * SC_W, q[6 * 33] * SC_W, q[7 * 33] * SC_W);
            *(u32x2*)((unsigned char*)t.dst + (size_t)n * 1024 + 8 * c) = o; }
        else { u32x4 o; o.x = cvt_pk_bf16(q[0 * 33], q[1 * 33]); o.y = cvt_pk_bf16(q[2 * 33], q[3 * 33]); o.z = cvt_pk_bf16(q[4 * 33], q[5 * 33]); o.w = cvt_pk_bf16(q[6 * 33], q[7 * 33]);
            *(u32x4*)((bf16*)t.dst + (size_t)n * 1024 + 8 * c) = o; } }
    LDS_WAIT(); asm volatile("" ::: "memory");
}
__device__ __forceinline__ void meta_unit(Frame& F, int mu) {
    LAS float* nmT = (LAS float*)F.lds;
    LAS float* part = (LAS float*)(F.lds + 65536);
    LAS float* rs = (LAS float*)(F.aux + A_RED);
    const int type = mu >> 3, hh = mu & 7, lane = F.lane, w = F.wave;
    for (int r = 2 * w; r < 2 * w + 2; ++r) { float s = 0.f; for (int k = lane; k < DM; k += 64) { const float v = F.meta[r * DM + k]; s += v * v; } s = wave_sum(s); if (lane == 0) rs[r] = __builtin_amdgcn_rsqf(s * (1.0f / DM) + EPS); }
    __syncthreads();
    for (int idx = F.tid; idx < NMETA * DM; idx += 512) { const int r = idx >> 10, k = idx & 1023; nmT[k * 16 + r] = F.meta[idx] * rs[r] * F.g1[k]; }
    __syncthreads();
    const int col = (type == 0 ? 512 : type == 1 ? 1024 : 1536) + 64 * hh + lane, colg = 2048 + 64 * hh + lane;
    float a1[16], a2[16];
#pragma unroll
    for (int r = 0; r < 16; ++r) { a1[r] = 0.f; a2[r] = 0.f; }
    for (int k = 128 * w; k < 128 * w + 128; ++k) {
        const float wv = F.w_in[(size_t)k * INC + col]; const float wg = (type == 2) ? F.w_in[(size_t)k * INC + colg] : 0.f;
        const LAS f32x4* np = (const LAS f32x4*)(nmT + k * 16);
#pragma unroll
        for (int q = 0; q < 4; ++q) { const f32x4 nv = np[q];
#pragma unroll
            for (int e = 0; e < 4; ++e) { a1[4 * q + e] += nv[e] * wv; a2[4 * q + e] += nv[e] * wg; } }
    }
#pragma unroll
    for (int r = 0; r < 16; ++r) { part[(w * 16 + r) * 64 + lane] = a1[r]; part[8192 + (w * 16 + r) * 64 + lane] = a2[r]; }
    __syncthreads();
    for (int r = 2 * w; r < 2 * w + 2; ++r) {
        float v = 0.f, v2 = 0.f;
#pragma unroll
        for (int ww = 0; ww < 8; ++ww) { v += part[(ww * 16 + r) * 64 + lane]; v2 += part[8192 + (ww * 16 + r) * 64 + lane]; }
        if (type == 0) { const float ss = wave_sum(v * v); const bf16 o = f2bf(v * __builtin_amdgcn_rsqf(ss * (1.0f / 64.0f) + EPS) * F.kg[lane]);
            for (int b = 0; b < NB; ++b) F.Kh[((size_t)(b * NH + hh) * LP + LPAD + r) * HD + lane] = o; }
        else if (type == 1) { const bf16 o = f2bf(v); for (int b = 0; b < NB; ++b) F.VT[((size_t)(b * NH + hh) * HD + lane) * LP + LPAD + r] = o; }
        else { const bf16 o = f2bf(v * sigmoidf_(v2)); for (int b = 0; b < NB; ++b) F.HCV[((size_t)b * LP + LPAD + r) * CW + 64 * hh + lane] = o; }
    }
    __syncthreads();
}
__device__ __forceinline__ void p0_prologue(Frame& F) {
    if (F.vcu < 24) meta_unit(F, F.vcu);
    for (int mu = F.vcu + F.G; mu < 24; mu += F.G) meta_unit(F, mu);
    LAS float* scr = (LAS float*)(F.lds + F.wave * 16384);
    const int gw = F.vcu * NWAVES + F.wave, NGW = F.G * NWAVES, lane = F.lane;
    for (int it = gw; it < 192; it += NGW) {
        const u32x4 z = (u32x4){0u, 0u, 0u, 0u};
        if (it < 64) { u32x4* p = (u32x4*)(F.Kh + (size_t)it * LP * HD); p[lane] = z; p[64 + lane] = z; }
        else if (it < 128) { u32x4* p = (u32x4*)(F.VT + ((size_t)(it - 64) * HD + lane) * LP); p[0] = z; p[1] = z; }
        else { const int j = it - 128, b = j >> 3, rr = (j & 7) * 2; u32x4* p = (u32x4*)(F.HCV + ((size_t)b * LP + rr) * CW); p[lane] = z; p[64 + lane] = z; }
    }
    constexpr int I_IN = 16 * 80, I_O = 16 * 32, I_UP = NE * 16 * 64, I_DN = NE * 16 * 32, NITEMS = I_IN + I_O + I_UP + I_DN;
    auto decode = [&](int it, TrItem& t) {
        int r = it;
        if (r < I_IN) { const int kb = r / 80, nb = r % 80; t.src = F.w_in + (size_t)(64 * kb) * INC + 32 * nb; t.N = INC; t.g = F.g1 + 64 * kb; t.dst = F.WinT + (size_t)win_dest(32 * nb) * 1024 + 64 * kb; t.f8 = 0; return; } r -= I_IN;
        if (r < I_O) { const int kb = r / 32, nb = r % 32; t.src = F.w_out + (size_t)(64 * kb) * DM + 32 * nb; t.N = DM; t.g = nullptr; t.dst = F.WoT + (size_t)(32 * nb) * 1024 + 64 * kb; t.f8 = 0; return; } r -= I_O;
        if (r < I_UP) { const int e = r >> 10, rr = r & 1023, kb = rr >> 6, nb = rr & 63; t.src = F.w_up + (size_t)e * DM * 2048 + (size_t)(64 * kb) * 2048 + 32 * nb; t.N = 2048; t.g = F.g2 + 64 * kb;
            t.dst = F.WupT + ((size_t)e * 2048 + wup_dest(32 * nb)) * 1024 + 64 * kb; t.f8 = 1; return; } r -= I_UP;
        { const int e = r >> 9, rr = r & 511, kb = rr >> 5, nb = rr & 31; t.src = F.w_dn + (size_t)e * DE * DM + (size_t)(64 * kb) * DM + 32 * nb; t.N = DM; t.g = nullptr;
            t.dst = F.WdT + ((size_t)e * DM + 32 * nb) * 1024 + 64 * kb; t.f8 = 1; }
    };
    {
        TrItem cur, nx; f32x4 va[8], vb[8]; float ga[8], gb[8];
        int it = gw;
        if (it < NITEMS) { decode(it, cur); tr_load(cur, va, ga, lane); }
        while (it < NITEMS) {
            const int nit = it + NGW;
            if (nit < NITEMS) { decode(nit, nx); tr_load(nx, vb, gb, lane); }
            tr_store(cur, va, ga, scr, lane);
            cur = nx; it = nit;
#pragma unroll
            for (int i = 0; i < 8; ++i) { va[i] = vb[i]; ga[i] = gb[i]; }
        }
    }
    for (int m = gw; m < NTOK; m += 2 * NGW) {
        const int m2 = (m + NGW < NTOK) ? m + NGW : m;
        const f32x4* xr = (const f32x4*)(F.x + (size_t)m * DM) + lane; const f32x4* xr2 = (const f32x4*)(F.x + (size_t)m2 * DM) + lane;
        f32x4 v[4], w[4]; float s = 0.f, s2 = 0.f;
#pragma unroll
        for (int j = 0; j < 4; ++j) { v[j] = xr[64 * j]; w[j] = xr2[64 * j]; }
#pragma unroll
        for (int j = 0; j < 4; ++j) { s += (v[j].x * v[j].x + v[j].y * v[j].y) + (v[j].z * v[j].z + v[j].w * v[j].w); s2 += (w[j].x * w[j].x + w[j].y * w[j].y) + (w[j].z * w[j].z + w[j].w * w[j].w); }
        const float rstd = __builtin_amdgcn_rsqf(wave_sum(s) * (1.0f / DM) + EPS), rstd2 = __builtin_amdgcn_rsqf(wave_sum(s2) * (1.0f / DM) + EPS);
        u32x2* o8 = (u32x2*)(F.NM + (size_t)m * DM) + lane; u32x2* o82 = (u32x2*)(F.NM + (size_t)m2 * DM) + lane;
#pragma unroll
        for (int j = 0; j < 4; ++j) { u32x2 o; o.x = cvt_pk_bf16(v[j].x * rstd, v[j].y * rstd); o.y = cvt_pk_bf16(v[j].z * rstd, v[j].w * rstd); o8[64 * j] = o;
            u32x2 o2; o2.x = cvt_pk_bf16(w[j].x * rstd2, w[j].y * rstd2); o2.y = cvt_pk_bf16(w[j].z * rstd2, w[j].w * rstd2); o82[64 * j] = o2; }
    }
}

__device__ __forceinline__ void conv_phase(Frame& F) {
    const int c = F.tid, lane = F.lane;
    LAS float* red = (LAS float*)(F.aux + A_RED); LAS float* tot = (LAS float*)(F.aux + A_TOT);
    float w[CKW];
#pragma unroll
    for (int j = 0; j < CKW; ++j) w[j] = F.conv_w[j * CW + c];
    const float cb = F.conv_b[c], lg = F.ln_g[c], lb = F.ln_b[c];
    for (int u = F.vcu; u < NTOK / 16; u += F.G) {
        const int t0 = u * 16, b = t0 >> 12, tb = t0 & 4095;
        const bf16* hp = F.HCV + ((size_t)b * LP + tb + 2) * CW + c;
        float h[46];
#pragma unroll
        for (int i = 0; i < 46; ++i) h[i] = bf2f(hp[(size_t)i * CW]);
        float v[16], rr[32];
#pragma unroll
        for (int j = 0; j < 16; ++j) { float s = cb;
#pragma unroll
            for (int k = 0; k < CKW; ++k) s += w[k] * h[j + k];
            v[j] = s; rr[j] = s; rr[16 + j] = s * s; }
        wave_reduce32(rr);
        if ((lane & 15) == 0) {
#pragma unroll
            for (int i = 0; i < 8; ++i) red[F.wave * 32 + 8 * (lane >> 4) + i] = rr[i]; }
        __syncthreads();
        if (F.tid < 32) { float s = 0.f;
#pragma unroll
            for (int ww = 0; ww < 8; ++ww) s += red[ww * 32 + F.tid]; tot[F.tid] = s; }
        __syncthreads();
#pragma unroll
        for (int j = 0; j < 16; ++j) { const float mean = tot[j] * (1.0f / CW), var = fmaxf(tot[16 + j] * (1.0f / CW) - mean * mean, 0.f);
            const float y = (v[j] - mean) * __builtin_amdgcn_rsqf(var + EPS) * lg + lb;
            F.NM[(size_t)(t0 + j) * DM + SBW + c] = f2bf(y * sigmoidf_(y)); }
    }
}

template <bool EARLY>
__device__ __forceinline__ void attn_wave_unit(Frame& F, int bh, int qb, LAS float* stg) {
    const int lane = F.lane, r = lane & 31, hf = lane >> 5;
    const bf16* qp = F.Q + ((size_t)bh * SEQ + qb * 32 + r) * HD + 8 * hf;
    bf16x8 qf[4];
#pragma unroll
    for (int s = 0; s < 4; ++s) qf[s] = *(const bf16x8*)(qp + 16 * s);
    const int krow = (r & ~12) | ((r & 4) << 1) | ((r & 8) >> 1);
    const bf16* kp = F.Kh + ((size_t)bh * LP + krow) * HD + 8 * hf;
    const bf16* vp = F.VT + ((size_t)bh * HD + r) * LP + 8 * hf;
    f32x16 o0, o1;
#pragma unroll
    for (int i = 0; i < 16; ++i) { o0[i] = 0.f; o1[i] = 0.f; }
    float C = 1.0f;
    int jb = qb + 1;
    bf16x8 kf[4], vf[4], kn[4], vn[4];
#define LOADKV(KF, VF, J) do { _Pragma("unroll") for (int s = 0; s < 4; ++s) KF[s] = *(const bf16x8*)(kp + (size_t)(J) * 32 * HD + 16 * s); \
        _Pragma("unroll") for (int d = 0; d < 2; ++d) _Pragma("unroll") for (int s = 0; s < 2; ++s) VF[d * 2 + s] = *(const bf16x8*)(vp + (size_t)d * 32 * LP + (J) * 32 + 16 * s); } while (0)
    LOADKV(kf, vf, jb);
    for (;;) {
        const int jn = jb > 0 ? jb - 1 : 0;
        LOADKV(kn, vn, jn);
        f32x16 st;
#pragma unroll
        for (int i = 0; i < 16; ++i) st[i] = 0.f;
#pragma unroll
        for (int s = 0; s < 4; ++s) st = __builtin_amdgcn_mfma_f32_32x32x16_bf16(kf[s], qf[s], st, 0, 0, 0);
        const bool diag = (jb == qb + 1), first = (jb == 0);
        float be[16], ke[16];
#pragma unroll
        for (int i = 0; i < 16; ++i) {
            const int c = 16 * (i >> 3) + 8 * hf + (i & 7);
            const float u = fast_exp2(-st[i]);
            const float bt = fast_rcp(1.0f + u);
            const bool valid = diag ? (c < r) : (first ? (c >= 16) : true);
            be[i] = valid ? bt : 0.f; ke[i] = valid ? u * bt : 1.0f;
        }
        float plo = ke[0], phi = ke[8];
#pragma unroll
        for (int i = 1; i < 8; ++i) { plo *= ke[i]; phi *= ke[8 + i]; }
        const float plo_o = __shfl_xor(plo, 32), phi_o = __shfl_xor(phi, 32);
        const float X1 = phi * phi_o, X0 = plo * plo_o, CX1 = C * X1;
        float run = hf ? C : C * phi_o;
        float a[16];
#pragma unroll
        for (int i = 15; i >= 8; --i) { a[i] = be[i] * run; run *= ke[i]; }
        run = hf ? CX1 : CX1 * plo_o;
#pragma unroll
        for (int i = 7; i >= 0; --i) { a[i] = be[i] * run; run *= ke[i]; }
        C = CX1 * X0;
        u32x4 p0, p1;
        p0.x = cvt_pk_bf16(a[0], a[1]); p0.y = cvt_pk_bf16(a[2], a[3]); p0.z = cvt_pk_bf16(a[4], a[5]); p0.w = cvt_pk_bf16(a[6], a[7]);
        p1.x = cvt_pk_bf16(a[8], a[9]); p1.y = cvt_pk_bf16(a[10], a[11]); p1.z = cvt_pk_bf16(a[12], a[13]); p1.w = cvt_pk_bf16(a[14], a[15]);
        const bf16x8 af0 = __builtin_bit_cast(bf16x8, p0), af1 = __builtin_bit_cast(bf16x8, p1);
        o0 = __builtin_amdgcn_mfma_f32_32x32x16_bf16(af0, vf[0], o0, 0, 0, 0); o0 = __builtin_amdgcn_mfma_f32_32x32x16_bf16(af1, vf[1], o0, 0, 0, 0);
        o1 = __builtin_amdgcn_mfma_f32_32x32x16_bf16(af0, vf[2], o1, 0, 0, 0); o1 = __builtin_amdgcn_mfma_f32_32x32x16_bf16(af1, vf[3], o1, 0, 0, 0);
        if (jb == 0) break;
        if (EARLY) { if (__all(C < ATTN_CUT)) break; }
        --jb;
#pragma unroll
        for (int s = 0; s < 4; ++s) { kf[s] = kn[s]; vf[s] = vn[s]; }
    }
#undef LOADKV
#pragma unroll
    for (int i = 0; i < 16; ++i) { const int q = (i & 3) + 8 * (i >> 2) + 4 * hf; stg[q * 68 + r] = o0[i]; stg[q * 68 + 32 + r] = o1[i]; }
    LDS_WAIT(); asm volatile("" ::: "memory");
    const int q = lane >> 1, half = lane & 1, h = bh & 7, b = bh >> 3;
    f32x4 v[8]; float ss = 0.f;
#pragma unroll
    for (int j = 0; j < 8; ++j) { v[j] = *(const LAS f32x4*)(stg + q * 68 + 32 * half + 4 * j); ss += (v[j].x * v[j].x + v[j].y * v[j].y) + (v[j].z * v[j].z + v[j].w * v[j].w); }
    ss += __shfl_xor(ss, 1);
    const float rstd = __builtin_amdgcn_rsqf(ss * (1.0f / 64.0f) + EPS);
    const float* gp = F.og + h * HD + 32 * half;
    bf16* dst = F.NM + ((size_t)(b * SEQ + qb * 32 + q)) * DM + h * HD + 32 * half;
#pragma unroll
    for (int j = 0; j < 4; ++j) { const f32x4 g0 = *(const f32x4*)(gp + 8 * j), g1 = *(const f32x4*)(gp + 8 * j + 4); const f32x4 a0 = v[2 * j] * rstd * g0, a1 = v[2 * j + 1] * rstd * g1;
        u32x4 w; w.x = cvt_pk_bf16(a0[0], a0[1]); w.y = cvt_pk_bf16(a0[2], a0[3]); w.z = cvt_pk_bf16(a1[0], a1[1]); w.w = cvt_pk_bf16(a1[2], a1[3]);
        *(u32x4*)(dst + 8 * j) = w; }
    LDS_WAIT(); asm volatile("" ::: "memory");
}
__device__ __forceinline__ void attn_phase(Frame& F) {
    LAS float* stg = (LAS float*)(F.lds + F.wave * 8704);
    for (int wu = F.vcu; wu < 64 * 16; wu += F.G) {
        const int bh = wu & 63, j = wu >> 6;
        const int i = j >> 2, j0 = j & 3;
        const int grp = (i == 0) ? j0 : (i == 1) ? 15 - j0 : (i == 2) ? 4 + j0 : 11 - j0;
        attn_wave_unit<ATTN_EARLY != 0>(F, bh, grp * 8 + F.wave, stg);
    }
}

template <int MODE> __device__ __forceinline__ void router_phase(Frame& F, const bool commit) {
    LAS float* Wt = (LAS float*)F.lds;
    LAS int* hist = (LAS int*)(F.aux + A_HIST); LAS int* base = (LAS int*)(F.aux + A_BASE);
    LAS int* sel_e = (LAS int*)(F.aux + A_SELE); LAS float* sel_g = (LAS float*)(F.aux + A_SELG); LAS int* rank = (LAS int*)(F.aux + A_RANK);
    const int lane = F.lane;
    if (!(MODE & 4)) {
#pragma unroll 8
    for (int idx = F.tid; idx < NE * DM; idx += 512) { const int k = idx >> 5, e = idx & 31; Wt[e * 1024 + k] = F.w_r[idx] * F.g2[k]; } }
    __syncthreads();
    const float br_me = F.b_r[lane >> 1];
    for (int blk = F.vcu; blk < NTOK / 128; blk += F.G) {
        if (F.tid < 32) hist[F.tid] = 0;
        f32x4 xn[4];
        { const f32x4* xr0 = (const f32x4*)(F.out + (size_t)(blk * 128 + F.wave * 16) * DM) + lane;
#pragma unroll
          for (int j = 0; j < 4; ++j) xn[j] = xr0[64 * j]; }
        for (int tl = F.wave * 16; tl < F.wave * 16 + 16; ++tl) {
            const int t = blk * 128 + tl;
            f32x4 xv[4]; float s = 0.f;
#pragma unroll
            for (int j = 0; j < 4; ++j) { xv[j] = xn[j]; s += (xv[j].x * xv[j].x + xv[j].y * xv[j].y) + (xv[j].z * xv[j].z + xv[j].w * xv[j].w); }
            { const int tn = (tl + 1 < F.wave * 16 + 16) ? t + 1 : t; const f32x4* xr1 = (const f32x4*)(F.out + (size_t)tn * DM) + lane;
#pragma unroll
              for (int j = 0; j < 4; ++j) xn[j] = xr1[64 * j]; }
            const float rstd = __builtin_amdgcn_rsqf(wave_sum(s) * (1.0f / DM) + EPS);
            unsigned* o8 = (unsigned*)(F.HN + (size_t)t * DM) + lane; const float rq = rstd * SC_HN;
#pragma unroll
            for (int j = 0; j < 4; ++j) o8[64 * j] = pack4_fp8(xv[j].x * rq, xv[j].y * rq, xv[j].z * rq, xv[j].w * rq);
            if (MODE & 8) { if (lane == 0) sel_e[tl * 4] = (int)rstd; continue; }
            float acc[32];
#pragma unroll
            for (int eb = 0; eb < 8; ++eb) {
#pragma unroll
                for (int e = 4 * eb; e < 4 * eb + 4; ++e) { float a = 0.f;
                    if (MODE & 1) { acc[e] = xv[e & 3].x * (float)e; continue; }
#pragma unroll
                    for (int j = 0; j < 4; ++j) { const f32x4 wv = *(const LAS f32x4*)(Wt + e * 1024 + 256 * j + 4 * lane); a += (xv[j].x * wv.x + xv[j].y * wv.y) + (xv[j].z * wv.z + xv[j].w * wv.w); }
                    acc[e] = a; }
                __builtin_amdgcn_sched_barrier(0);
            }
            const int e_me = lane >> 1;
            wave_reduce32(acc);
            float mine = acc[0];
#pragma unroll
            for (int i = 1; i < 8; ++i) mine = (((lane >> 1) & 7) == i) ? acc[i] : mine;
            float val = mine * rstd + br_me;
            int se[4]; float sv[4];
#pragma unroll
            for (int k = 0; k < 4; ++k) {
                if (MODE & 2) { se[k] = (lane + k) & 31; sv[k] = val; continue; }
                float bv = val; int bi = e_me;
#define RT_STEP(OV, OI) do { const float ov_ = (OV); const int oi_ = (OI); if (ov_ > bv || (ov_ == bv && oi_ < bi)) { bv = ov_; bi = oi_; } } while (0)
                RT_STEP(dpp_f<DPP_ROW_MIRROR>(bv), dpp_i<DPP_ROW_MIRROR>(bi));
                RT_STEP(dpp_f<DPP_ROW_HALF_MIRROR>(bv), dpp_i<DPP_ROW_HALF_MIRROR>(bi));
                RT_STEP(dpp_f<DPP_QUAD_REV>(bv), dpp_i<DPP_QUAD_REV>(bi));
                { const auto rv = __builtin_amdgcn_permlane16_swap(__float_as_uint(bv), __float_as_uint(bv), false, false); const auto ri = __builtin_amdgcn_permlane16_swap((unsigned)bi, (unsigned)bi, false, false);
                  float v0 = __uint_as_float(rv[0]), v1 = __uint_as_float(rv[1]); int i0 = (int)ri[0], i1 = (int)ri[1];
                  if (v1 > v0 || (v1 == v0 && i1 < i0)) { v0 = v1; i0 = i1; } bv = v0; bi = i0; }
                { const auto rv = __builtin_amdgcn_permlane32_swap(__float_as_uint(bv), __float_as_uint(bv), false, false); const auto ri = __builtin_amdgcn_permlane32_swap((unsigned)bi, (unsigned)bi, false, false);
                  float v0 = __uint_as_float(rv[0]), v1 = __uint_as_float(rv[1]); int i0 = (int)ri[0], i1 = (int)ri[1];
                  if (v1 > v0 || (v1 == v0 && i1 < i0)) { v0 = v1; i0 = i1; } bv = v0; bi = i0; }
#undef RT_STEP
                se[k] = bi; sv[k] = bv; if (e_me == bi) val = -INFINITY;
            }
            const float e1 = __expf(sv[1] - sv[0]), e2 = __expf(sv[2] - sv[0]), e3 = __expf(sv[3] - sv[0]); const float inv = 1.0f / (1.0f + e1 + e2 + e3);
            if (lane == 0) { sel_e[tl * 4 + 0] = se[0]; sel_e[tl * 4 + 1] = se[1]; sel_e[tl * 4 + 2] = se[2]; sel_e[tl * 4 + 3] = se[3];
                sel_g[tl * 4 + 0] = inv; sel_g[tl * 4 + 1] = e1 * inv; sel_g[tl * 4 + 2] = e2 * inv; sel_g[tl * 4 + 3] = e3 * inv; }
        }
        __syncthreads();
        const int a = F.tid, ea = sel_e[a];
        rank[a] = __hip_atomic_fetch_add(hist + ea, 1, __ATOMIC_RELAXED, __HIP_MEMORY_SCOPE_WORKGROUP);
        __syncthreads();
        if (F.tid < 32 && commit) base[F.tid] = (int)__hip_atomic_fetch_add((unsigned*)(F.ctl + CW_CNT + 64 * F.tid), (unsigned)hist[F.tid], RLX_AGENT);
        __syncthreads();
        if (commit) { const int pos = base[ea] + rank[a], t = blk * 128 + (a >> 2);
          F.rtok[(size_t)ea * CAP + pos] = t; F.rgate[(size_t)ea * CAP + pos] = sel_g[a]; F.tslot[(size_t)t * 4 + (a & 3)] = ((unsigned)ea << 16) | (unsigned)pos; }
        __syncthreads();
    }
}

__device__ __forceinline__ void moe_setup(Frame& F) {
    LAS int* tpre = (LAS int*)(F.aux + A_TPRE); LAS int* cnt = (LAS int*)(F.aux + A_CNT);
    if (F.tid < 32) cnt[F.tid] = (int)__hip_atomic_load((unsigned*)(F.ctl + CW_CNT + 64 * F.tid), RLX_AGENT);
    __syncthreads();
    if (F.tid == 0) { int s = 0; for (int e = 0; e < NE; ++e) { tpre[e] = s; s += (cnt[e] + 255) >> 8; } tpre[NE] = s; }
    __syncthreads();
}

__device__ __forceinline__ void combine_phase(Frame& F, float* dstbase) {
    const LAS int* tpre = (const LAS int*)(F.aux + A_TPRE);
    const int gw = F.vcu * NWAVES + F.wave, NGW = F.G * NWAVES, lane = F.lane;
    for (int t = gw; t < NTOK; t += 2 * NGW) {
        const int t2 = (t + NGW < NTOK) ? t + NGW : t;
        const u32x4 sa = *(const u32x4*)(F.tslot + (size_t)t * 4), sb = *(const u32x4*)(F.tslot + (size_t)t2 * 4);
        f32x4* orow = (f32x4*)(F.out + (size_t)t * DM) + lane; f32x4* orow2 = (f32x4*)(F.out + (size_t)t2 * DM) + lane;
        f32x4 v[4], w[4];
#pragma unroll
        for (int j = 0; j < 4; ++j) { v[j] = orow[64 * j]; w[j] = orow2[64 * j]; }
        u32x2 ya[4][4], yb[4][4];
#pragma unroll
        for (int k = 0; k < 4; ++k) {
            const unsigned s1 = sa[k], s2 = sb[k];
            const u32x2* y1 = (const u32x2*)(F.Y + ((size_t)tpre[s1 >> 16] * 256 + (s1 & 0xffffu)) * DM) + lane;
            const u32x2* y2 = (const u32x2*)(F.Y + ((size_t)tpre[s2 >> 16] * 256 + (s2 & 0xffffu)) * DM) + lane;
#pragma unroll
            for (int j = 0; j < 4; ++j) { ya[k][j] = y1[64 * j]; yb[k][j] = y2[64 * j]; }
        }
#pragma unroll
        for (int k = 0; k < 4; ++k)
#pragma unroll
            for (int j = 0; j < 4; ++j) {
                v[j].x += __uint_as_float(ya[k][j].x << 16); v[j].y += __uint_as_float(ya[k][j].x & 0xffff0000u); v[j].z += __uint_as_float(ya[k][j].y << 16); v[j].w += __uint_as_float(ya[k][j].y & 0xffff0000u);
                w[j].x += __uint_as_float(yb[k][j].x << 16); w[j].y += __uint_as_float(yb[k][j].x & 0xffff0000u); w[j].z += __uint_as_float(yb[k][j].y << 16); w[j].w += __uint_as_float(yb[k][j].y & 0xffff0000u); }
#pragma unroll
        for (int j = 0; j < 4; ++j) ((f32x4*)(dstbase + (size_t)t * DM) + lane)[64 * j] = v[j];
        if (t2 != t) {
#pragma unroll
            for (int j = 0; j < 4; ++j) ((f32x4*)(dstbase + (size_t)t2 * DM) + lane)[64 * j] = w[j]; }
    }
}

struct Args { const float* in[19]; float* out; unsigned char* ws; int ph_lo, ph_hi; };
template <int PLO, int PHI> __global__ void __launch_bounds__(NWAVES * 64, 2) hymba_fwd(Args args) {
    extern __shared__ __attribute__((aligned(16))) unsigned char lds[];
    Frame F;
    F.lds = (LAS unsigned char*)lds; F.aux = F.lds + AUX_OFF;
    F.tid = threadIdx.x; F.lane = F.tid & 63; F.wave = __builtin_amdgcn_readfirstlane(F.tid >> 6);
    F.G = gridDim.x; { const int bx = blockIdx.x; F.vcu = (F.G % 8 == 0) ? (bx % 8) * (F.G / 8) + bx / 8 : bx; }
    unsigned char* ws = args.ws;
    F.ctl = (gu32*)(ws + WS_CTL);
    F.x = args.in[0]; F.meta = args.in[1]; F.g1 = args.in[2]; F.w_in = args.in[3]; F.qg = args.in[4]; F.kg = args.in[5]; F.conv_w = args.in[6]; F.conv_b = args.in[7];
    F.ln_g = args.in[8]; F.ln_b = args.in[9]; F.og = args.in[10]; F.w_out = args.in[11]; F.g2 = args.in[12]; F.w_r = args.in[13]; F.b_r = args.in[14];
    F.w_up = args.in[15]; F.b_up = args.in[16]; F.w_dn = args.in[17]; F.b_dn = args.in[18]; F.out = args.out;
    F.WinT = (bf16*)(ws + WS_WIN); F.WoT = (bf16*)(ws + WS_WO); F.WdT = ws + WS_WD; F.WupT = ws + WS_WUP; F.NM = (bf16*)(ws + WS_NM);
    F.Q = (bf16*)(ws + WS_Q); F.Kh = (bf16*)(ws + WS_K); F.VT = (bf16*)(ws + WS_VT); F.HCV = (bf16*)(ws + WS_HCV); F.HN = ws + WS_HN; F.ACT = ws + WS_ACT; F.Y = (bf16*)(ws + WS_Y);
    F.rtok = (int*)(ws + WS_RTOK); F.rgate = (float*)(ws + WS_RGATE); F.tslot = (unsigned*)(ws + WS_TSLOT);
    for (int u = F.tid; u < 512 / 4; u += NWAVES * 64) ((LAS unsigned*)(F.lds + LDSCTL_OFF))[u] = 0u;
    __syncthreads();
    XcdBarrier bar; bar.bar = (unsigned*)(F.ctl + CW_BAR); bar.x = 0; bar.st = nullptr;
    if (PHI - PLO > 1) bar = xcd_barrier_post((unsigned*)(F.ctl + CW_BAR), (volatile LAS unsigned*)(F.lds + MISC_OFF) + 8);
    constexpr int lo = PLO, hi = PHI;
#ifndef PH_MASK
#define PH_MASK 0xff
#endif
#define IN(k) (((PH_MASK >> (k)) & 1) && lo <= (k) && (k) < hi)
#define SEAM(k) do { if (IN(k) && IN((k) + 1)) xcd_barrier(bar); } while (0)
    bool moe_ready = false;
#define FRESH() do { int t_ = threadIdx.x; asm volatile("" : "+v"(t_)); F.tid = t_; F.lane = t_ & 63; F.wave = __builtin_amdgcn_readfirstlane(t_ >> 6); } while (0)

    if (IN(0)) { FRESH(); p0_prologue(F); if (NREP(0) > 1) { __syncthreads(); FRESH(); p0_prologue(F); } SEAM(0); }
    if (IN(1)) { FRESH();
        pg8::StaticSched S; S.init(NTOK, INC, DM, F.WinT, F.G, (int)blockIdx.x);
        pg8::EpiIn E{F.Q, F.Kh, F.VT, F.HCV, F.qg, F.kg};
        pg8::gemm_phase(F.lds, (const char*)F.NM, DM * 2, S, E, F.tid); if (NREP(1) > 1) { FRESH(); pg8::gemm_phase(F.lds, (const char*)F.NM, DM * 2, S, E, F.tid); }
        SEAM(1);
    }
    if (IN(2)) { FRESH(); conv_phase(F); if (NREP(2) > 1) { __syncthreads(); FRESH(); conv_phase(F); } __syncthreads(); attn_phase(F); if (NREP(7) > 1) { __syncthreads(); FRESH(); attn_phase(F); } SEAM(2); }
    if (IN(3)) { FRESH();
        pg8::StaticSched S; S.init(NTOK, DM, DM, F.WoT, F.G, (int)blockIdx.x);
        pg8::EpiRes E{F.x, F.out};
        pg8::gemm_phase(F.lds, (const char*)F.NM, DM * 2, S, E, F.tid); if (NREP(3) > 1) { FRESH(); pg8::gemm_phase(F.lds, (const char*)F.NM, DM * 2, S, E, F.tid); }
        SEAM(3);
    }
    if (IN(4)) { FRESH(); if (NREP(4) > 1) { router_phase<(NREP(4) > 1 ? (int)NREP(4) - 2 : 0)>(F, false); __syncthreads(); FRESH(); } router_phase<0>(F, true); SEAM(4); }
    if (IN(5)) { FRESH();
        if (!moe_ready) { moe_setup(F); moe_ready = true; }
        const LAS int* tpre = (const LAS int*)(F.aux + A_TPRE); const LAS int* cnt = (const LAS int*)(F.aux + A_CNT);
        LAS unsigned* idx = (LAS unsigned*)(F.aux + A_IDX);
        pg8::MoeSched<true> S; S.G = F.G; S.v = F.vcu; S.NT = 8; S.ntot = tpre[NE]; S.K2 = 1024u; S.Bt = (const char*)F.WupT; S.bstride = (size_t)2048 * 1024; S.tpre = tpre; S.idx = idx;
        { unsigned tkv[MAXU];
#pragma unroll
          for (int i = 0; i < MAXU; ++i) { pg8::Unit u; const bool ok = S.next(i, u); const int lr = u.rt * 256 + (F.tid & 255);
              tkv[i] = (ok && F.tid < 256 && lr < cnt[u.e]) ? (unsigned)F.rtok[(size_t)u.e * CAP + lr] : 0u; }
#pragma unroll
          for (int i = 0; i < MAXU; ++i) if (F.tid < 256) idx[i * 256 + F.tid] = tkv[i] * 1024u; }
        __syncthreads();
        pg8::EpiUp E{F.ACT, F.b_up};
        pg8::gemm_phase(F.lds, (const char*)F.HN, DM, S, E, F.tid); if (NREP(5) > 1) { FRESH(); pg8::gemm_phase(F.lds, (const char*)F.HN, DM, S, E, F.tid); }
        SEAM(5);
    }
    if (IN(6)) { FRESH();
        if (!moe_ready) { moe_setup(F); moe_ready = true; }
        const LAS int* tpre = (const LAS int*)(F.aux + A_TPRE);
        pg8::MoeSched<false> S; S.G = F.G; S.v = F.vcu; S.NT = 4; S.ntot = tpre[NE]; S.K2 = 1024u; S.Bt = (const char*)F.WdT; S.bstride = (size_t)1024 * 1024; S.tpre = tpre; S.idx = nullptr;
        pg8::EpiDown E{F.Y, F.b_dn, F.rgate};
        pg8::gemm_phase(F.lds, (const char*)F.ACT, DE, S, E, F.tid); if (NREP(6) > 1) { FRESH(); pg8::gemm_phase(F.lds, (const char*)F.ACT, DE, S, E, F.tid); }
        SEAM(6);
    }
    if (IN(7)) { FRESH();
        if (!moe_ready) { moe_setup(F); moe_ready = true; }
        if (PROBE_P7) { combine_phase(F, (float*)(ws + WS_ACT)); __syncthreads(); FRESH(); }
        combine_phase(F, F.out);
    }
#undef IN
#undef SEAM
}

template <int PLO, int PHI> static bool launch_range(int& grid, const Args& a, hipStream_t stream) {
    static bool ready = false;
    if (!ready) {
        int dev = 0, cus = 0, per_cu = 0;
        if (hipGetDevice(&dev) != hipSuccess || hipDeviceGetAttribute(&cus, hipDeviceAttributeMultiprocessorCount, dev) != hipSuccess) return false;
        if (hipFuncSetAttribute((const void*)hymba_fwd<PLO, PHI>, hipFuncAttributeMaxDynamicSharedMemorySize, LDS_BYTES) != hipSuccess) { fprintf(stderr, "kernel_launch: hipFuncSetAttribute failed\n"); return false; }
        if (hipOccupancyMaxActiveBlocksPerMultiprocessor(&per_cu, (const void*)hymba_fwd<PLO, PHI>, NWAVES * 64, LDS_BYTES) != hipSuccess || per_cu < 1) fprintf(stderr, "kernel_launch: occupancy query says %d\n", per_cu);
        (void)hipGetLastError();
        grid = cus;
        ready = true;
    }
    hipLaunchKernelGGL((hymba_fwd<PLO, PHI>), dim3(grid), dim3(NWAVES * 64), LDS_BYTES, stream, a);
    return true;
}
extern "C" void kernel_launch(void* const* d_in, const int* in_sizes, int n_in, void* d_out, int out_size, void* d_ws, size_t ws_size, hipStream_t stream) {
    static int grid = 0;
    if (grid < 0) return;
    if (n_in != 19 || in_sizes[0] != NTOK * DM || out_size != NTOK * DM || ws_size < WS_END) { fprintf(stderr, "kernel_launch: unexpected shapes (n_in %d, ws %zu); nothing launched\n", n_in, ws_size); grid = -1; return; }
    if (hipMemsetAsync((char*)d_ws + WS_CTL, 0, CTL_ZERO_BYTES, stream) != hipSuccess) return;
    Args a{};
    for (int i = 0; i < 19; ++i) a.in[i] = (const float*)d_in[i];
    a.out = (float*)d_out; a.ws = (unsigned char*)d_ws; a.ph_lo = 0; a.ph_hi = 8;
#if MK_N_LAUNCHES == 1
    if (!launch_range<0, 8>(grid, a, stream)) grid = -1;
#else
    bool ok = launch_range<0, 1>(grid, a, stream) && launch_range<1, 2>(grid, a, stream) && launch_range<2, 3>(grid, a, stream) && launch_range<3, 4>(grid, a, stream)
           && launch_range<4, 5>(grid, a, stream) && launch_range<5, 6>(grid, a, stream) && launch_range<6, 7>(grid, a, stream) && launch_range<7, 8>(grid, a, stream);
    if (!ok) grid = -1;
#endif
}
```

```cpp
#include <hip/hip_runtime.h>
#include <cstdio>
#include <cstdint>

#ifndef MK_N_LAUNCHES
#define MK_N_LAUNCHES 1
#endif
#ifndef PROBE_REP
#define PROBE_REP 0
#endif
#ifndef PROBE_P7
#define PROBE_P7 0
#endif
#define NREP(k) ((((unsigned)PROBE_REP >> (4 * (k))) & 15u) + 1u)
#ifndef ATTN_EARLY
#define ATTN_EARLY 1
#endif

#define LAS __attribute__((address_space(3)))
#define GAS __attribute__((address_space(1)))
typedef unsigned short bf16;
typedef short bf16x8 __attribute__((ext_vector_type(8)));
typedef float f32x2 __attribute__((ext_vector_type(2)));
typedef float f32x4 __attribute__((ext_vector_type(4)));
typedef float f32x16 __attribute__((ext_vector_type(16)));
typedef unsigned u32x2 __attribute__((ext_vector_type(2)));
typedef unsigned u32x4 __attribute__((ext_vector_type(4)));
typedef GAS unsigned gu32;
typedef int i32x8 __attribute__((ext_vector_type(8)));

constexpr int NB = 8, SEQ = 4096, DM = 1024, NTOK = NB * SEQ;
constexpr int NMETA = 16, LPAD = 16, LP = LPAD + NMETA + SEQ;
constexpr int NH = 8, HD = 64, SBW = 512, CW = 512, CKW = 31, INC = 2560;
constexpr int NE = 32, TOPK = 4, DE = 1024, CAP = NTOK;
constexpr int MAXROWS = NTOK * TOPK + NE * 256;
constexpr float EPS = 1e-6f;
constexpr float LOG2E = 1.4426950408889634f;
constexpr float QSCALE = 0.125f * LOG2E;
constexpr float SW_LIMIT = 7.0f, SW_ALPHA = 1.702f;
constexpr float ATTN_CUT = 1e-30f;
constexpr float SC_W = 128.0f, SC_HN = 8.0f, SC_ACT = 4.0f, F8_MAX = 448.0f;

constexpr size_t MiB = 1u << 20;
constexpr size_t WS_CTL = 0, CTL_ZERO_BYTES = 1 * MiB;
constexpr size_t WS_WIN = 1 * MiB, WS_WO = 6 * MiB, WS_WD = 8 * MiB, WS_WUP = 72 * MiB;
constexpr size_t WS_NM = 200 * MiB;
constexpr size_t WS_Q = 264 * MiB, WS_K = 296 * MiB, WS_VT = 329 * MiB, WS_HCV = 362 * MiB;
constexpr size_t WS_ACT = 395 * MiB;
constexpr size_t WS_RTOK = 667 * MiB, WS_RGATE = 671 * MiB, WS_TSLOT = 675 * MiB, WS_END = 676 * MiB;
constexpr size_t WS_HN = WS_Q;
constexpr size_t WS_Y = WS_WUP;
static_assert(WS_Y + (size_t)MAXROWS * 2048 <= WS_HCV && WS_ACT + (size_t)MAXROWS * 2048 <= WS_RTOK, "ws map");
constexpr int CW_TMO = 0, CW_BAR = 4096, CW_CNT = 8192;

constexpr int RING_BYTES = 131072;
constexpr int LDSCTL_OFF = RING_BYTES, MISC_OFF = LDSCTL_OFF + 320, AUX_OFF = LDSCTL_OFF + 512;
constexpr int A_TPRE = 0, A_CNT = 256, A_HIST = 384, A_BASE = 512, A_RED = 640, A_TOT = 1664, A_SELE = 1792, A_SELG = 3840, A_RANK = 5888, A_IDX = 8192;
constexpr int MAXU = 17;
constexpr int LDS_BYTES = AUX_OFF + A_IDX + MAXU * 1024;
static_assert(LDS_BYTES <= 163840, "LDS");
constexpr int NWAVES = 8;

#define LDS_WAIT() asm volatile("s_waitcnt lgkmcnt(0)" ::: "memory")
#define VM_WAIT() asm volatile("s_waitcnt vmcnt(0)" ::: "memory")
#define RLX_AGENT __ATOMIC_RELAXED, __HIP_MEMORY_SCOPE_AGENT

__device__ __forceinline__ unsigned cvt_pk_bf16(float lo, float hi) { unsigned r; asm volatile("v_cvt_pk_bf16_f32 %0, %1, %2" : "=v"(r) : "v"(lo), "v"(hi)); return r; }
__device__ __forceinline__ float bf2f(bf16 b) { return __uint_as_float(((unsigned)b) << 16); }
__device__ __forceinline__ bf16 f2bf(float f) { return (bf16)(cvt_pk_bf16(f, 0.f) & 0xffffu); }
__device__ __forceinline__ unsigned pack4_fp8(float a, float b, float c, float d) {
    a = __builtin_amdgcn_fmed3f(a, -F8_MAX, F8_MAX); b = __builtin_amdgcn_fmed3f(b, -F8_MAX, F8_MAX); c = __builtin_amdgcn_fmed3f(c, -F8_MAX, F8_MAX); d = __builtin_amdgcn_fmed3f(d, -F8_MAX, F8_MAX);
    int p = __builtin_amdgcn_cvt_pk_fp8_f32(a, b, 0, false); p = __builtin_amdgcn_cvt_pk_fp8_f32(c, d, p, true); return (unsigned)p;
}
__device__ __forceinline__ float fast_rcp(float x) { return __builtin_amdgcn_rcpf(x); }
__device__ __forceinline__ float fast_exp2(float x) { return __builtin_amdgcn_exp2f(x); }
__device__ __forceinline__ float sigmoidf_(float x) { return fast_rcp(1.0f + fast_exp2(-x * LOG2E)); }
template <int CTRL> __device__ __forceinline__ float dpp_f(float v) { return __builtin_bit_cast(float, __builtin_amdgcn_update_dpp(0, __builtin_bit_cast(int, v), CTRL, 0xf, 0xf, true)); }
template <int CTRL> __device__ __forceinline__ int dpp_i(int v) { return __builtin_amdgcn_update_dpp(0, v, CTRL, 0xf, 0xf, true); }
#define DPP_ROW_MIRROR 0x140
#define DPP_ROW_HALF_MIRROR 0x141
#define DPP_QUAD_REV 0x1B
#define DPP_QUAD_SWAP 0xB1
__device__ __forceinline__ float row_allsum(float v) {
    v += dpp_f<DPP_ROW_MIRROR>(v); v += dpp_f<DPP_ROW_HALF_MIRROR>(v); v += dpp_f<DPP_QUAD_REV>(v); v += dpp_f<DPP_QUAD_SWAP>(v); return v;
}
__device__ __forceinline__ float swap16_sum(float a, float b) {
    const auto r = __builtin_amdgcn_permlane16_swap(__float_as_uint(a), __float_as_uint(b), false, false); return __uint_as_float(r[0]) + __uint_as_float(r[1]);
}
__device__ __forceinline__ float swap32_sum(float a, float b) {
    const auto r = __builtin_amdgcn_permlane32_swap(__float_as_uint(a), __float_as_uint(b), false, false); return __uint_as_float(r[0]) + __uint_as_float(r[1]);
}
__device__ __forceinline__ float wave_sum(float v) { v = row_allsum(v); v = swap16_sum(v, v); return swap32_sum(v, v); }
__device__ __forceinline__ void wave_reduce32(float (&v)[32]) {
#pragma unroll
    for (int i = 0; i < 16; ++i) v[i] = swap32_sum(v[i], v[i + 16]);
#pragma unroll
    for (int i = 0; i < 8; ++i) v[i] = swap16_sum(v[i], v[i + 8]);
#pragma unroll
    for (int i = 0; i < 8; ++i) v[i] = row_allsum(v[i]);
}
#define XB_TMO      128
#define XB_XCNT(j)  (256  + 64 * (j))
#define XB_XSUB(j)  (1280 + 64 * (j))
#define XB_XGEN(j)  (2304 + 64 * (j))
#define XB_TOP      3328
#define XB_TOPGEN   3392
#define XCD_BAR_WORDS 3456
#define XB_SPIN_CAP (1u << 18)
__device__ __forceinline__ unsigned xb_ld(unsigned* p)              { return __hip_atomic_load(p, __ATOMIC_RELAXED, __HIP_MEMORY_SCOPE_AGENT); }
__device__ __forceinline__ unsigned xb_add(unsigned* p, unsigned v) { return __hip_atomic_fetch_add(p, v, __ATOMIC_RELAXED, __HIP_MEMORY_SCOPE_AGENT); }
__device__ __forceinline__ unsigned xb_xcc_id() { return (unsigned)__builtin_amdgcn_s_getreg((3 << 11) | 20) & 0xFu; }
#define XB_SPIN(cond, bar) do { unsigned _sp = 0; while (cond) { __builtin_amdgcn_s_sleep(1); \
    if ((++_sp & 255u) == 0u) { if (xb_ld(&(bar)[XB_TMO])) break; if (_sp > XB_SPIN_CAP) { atomicAdd(&(bar)[XB_TMO], 1u); break; } } } } while (0)
struct XcdBarrier { unsigned* bar; unsigned x; volatile LAS unsigned* st; };
__device__ __forceinline__ XcdBarrier xcd_barrier_post(unsigned* bar, volatile LAS unsigned* st) {
    XcdBarrier b; b.bar = bar; b.x = xb_xcc_id(); b.st = st;
    if (threadIdx.x == 0) (void)xb_add(&bar[XB_XCNT(b.x)], 1u);
    return b;
}
__device__ __forceinline__ void xcd_barrier_complete(unsigned* bar, unsigned x, unsigned& nloc, unsigned& nx) {
    const unsigned G = gridDim.x * gridDim.y * gridDim.z;
    unsigned sum, cnt, mine, sp = 0u;
    for (;;) {
        sum = 0u; cnt = 0u; mine = 0u;
#pragma unroll
        for (unsigned j = 0; j < 16; ++j) { const unsigned c = xb_ld(&bar[XB_XCNT(j)]); sum += c; cnt += (c > 0u) ? 1u : 0u; mine = (j == x) ? c : mine; }
        if (sum == G) break;
        __builtin_amdgcn_s_sleep(1);
        if ((++sp & 255u) == 0u) { if (xb_ld(&bar[XB_TMO])) break; if (sp > XB_SPIN_CAP) { atomicAdd(&bar[XB_TMO], 1u); break; } }
    }
    nloc = mine > 0u ? mine : 1u; nx = cnt > 0u ? cnt : 1u;
}
__device__ __forceinline__ void xcd_barrier(const XcdBarrier& b) {
    asm volatile("s_waitcnt vmcnt(0)" ::: "memory");
    __syncthreads();
    if (threadIdx.x == 0) {
        unsigned* bar = b.bar;
        __builtin_amdgcn_s_waitcnt(0);
        unsigned nloc = b.st[0], nx = b.st[1];
        if (nloc == 0u) { xcd_barrier_complete(bar, b.x, nloc, nx); b.st[0] = nloc; b.st[1] = nx; }
        const unsigned old = xb_add(&bar[XB_XSUB(b.x)], 1u);
        const unsigned gen = old / nloc;
        if (old + 1u == (gen + 1u) * nloc) {
            __builtin_amdgcn_fence(__ATOMIC_RELEASE, "agent");
            asm volatile("s_waitcnt vmcnt(0)" ::: "memory");
            const unsigned og = xb_add(&bar[XB_TOP], 1u);
            const unsigned tg = og / nx;
            if (og + 1u == (tg + 1u) * nx) xb_add(&bar[XB_TOPGEN], 1u);
            else XB_SPIN(xb_ld(&bar[XB_TOPGEN]) == tg, bar);
            __builtin_amdgcn_fence(__ATOMIC_ACQUIRE, "agent");
            xb_add(&bar[XB_XGEN(b.x)], 1u);
            asm volatile("s_waitcnt vmcnt(0)" ::: "memory");
        } else {
            XB_SPIN(xb_ld(&bar[XB_XGEN(b.x)]) == gen, bar);
            __builtin_amdgcn_fence(__ATOMIC_ACQUIRE, "agent");
            asm volatile("s_waitcnt vmcnt(0)" ::: "memory");
        }
    }
    __syncthreads();
}

namespace pg8 {
constexpr int BM = 256, BK = 64, HALF = 128, HTB = HALF * BK * 2, STAGE_BYTES = 8 * HTB, NXCD = 8, WGM = 8;
__device__ __forceinline__ int lds_byte(int r, int c) { const int st = (r >> 4) * 2 + (c >> 5), rr = r & 15, cc = c & 31, ob = rr * 64 + cc * 2; return st * 1024 + (ob ^ (((ob >> 9) & 1) << 5)); }
__device__ __forceinline__ void stage_rc(int b, int& R, int& C) { const int st = b / 1024, sb = b % 1024, swz = sb ^ (((sb >> 9) & 1) << 5); R = (st >> 1) * 16 + swz / 64; C = (st & 1) * 32 + (swz % 64) / 2; }
__device__ __forceinline__ int perm32(int rho) { const int n = rho >> 4, i = rho & 15; return 8 * (i >> 2) + 4 * n + (i & 3); }

struct Unit { int pm, pn, e, rt; };

struct StaticSched {
    int nM, nN, nwg, G, c; unsigned K2; const char* Bt;
    __device__ void init(int M, int N, int K, const void* Bt_, int G_, int c_) { nM = M / BM; nN = N / BM; nwg = nM * nN; G = G_; c = c_; K2 = (unsigned)K * 2u; Bt = (const char*)Bt_; }
    __device__ __forceinline__ bool next(int i, Unit& u) const {
        const long L = (long)i * G + c; if (L >= nwg) return false;
        int wgid = (int)L; { const int q = nwg / NXCD, r = nwg % NXCD, xcd = wgid % NXCD, off = wgid / NXCD; wgid = (xcd < r ? xcd * (q + 1) : r * (q + 1) + (xcd - r) * q) + off; }
        const int nig = WGM * nN, gid = wgid / nig, fm = gid * WGM, gsz = (nM - fm) < WGM ? (nM - fm) : WGM;
        u.pm = fm + ((wgid % nig) % gsz); u.pn = (wgid % nig) / gsz; u.e = 0; u.rt = 0; return true;
    }
    __device__ __forceinline__ unsigned aoff(int, const Unit& u, int row) const { return (unsigned)(u.pm * BM + row) * K2; }
    __device__ __forceinline__ const char* bbase() const { return Bt; }
    __device__ __forceinline__ unsigned boff(const Unit& u) const { return (unsigned)(u.pn * BM) * K2; }
};
template <bool GATHER> struct MoeSched {
    int G, v, NT, ntot; unsigned K2; const char* Bt; size_t bstride; const LAS int* tpre; const LAS unsigned* idx;
    __device__ __forceinline__ bool next(int i, Unit& u) const {
        const int U = i * G + v; if (U >= ntot * NT) return false;
        const int rtg = U / NT; u.pm = rtg; u.pn = U - rtg * NT;
        int lo = 0, hi = NE;
#pragma unroll
        for (int s = 0; s < 5; ++s) { const int mid = (lo + hi) >> 1; const int t = __builtin_amdgcn_readfirstlane(tpre[mid]); if (rtg >= t) lo = mid; else hi = mid; }
        u.e = lo; u.rt = rtg - __builtin_amdgcn_readfirstlane(tpre[lo]); return true;
    }
    __device__ __forceinline__ unsigned aoff(int i, const Unit& u, int row) const { if (GATHER) return idx[i * 256 + row]; return (unsigned)(u.pm * BM + row) * K2; }
    __device__ __forceinline__ const char* bbase() const { return Bt; }
    __device__ __forceinline__ unsigned boff(const Unit& u) const { return (unsigned)u.e * (unsigned)bstride + (unsigned)(u.pn * BM) * K2; }
};

template <class Epi, class Sched>
__device__ __forceinline__ void gemm_phase(LAS unsigned char* lds, const char* Abase, const int KB  , const Sched& S, const Epi& E, const int tid) {
    const int wid = __builtin_amdgcn_readfirstlane(tid >> 6), lane = tid & 63, wr = wid >> 2, wc = wid & 3, fr = lane & 15, fq = lane >> 4;
    const int nt = KB / 128;
    int Rr[2]; unsigned colA[2], voffB[2];
#pragma unroll
    for (int i = 0; i < 2; ++i) { int R, C; stage_rc(tid * 16 + i * 8192, R, C); const int Rb = Epi::PERM ? ((R & ~31) + perm32(R & 31)) : R;
        Rr[i] = R; colA[i] = (unsigned)C * 2u; voffB[i] = (unsigned)(Rb * KB + C * 2); }
    const unsigned kstep = (unsigned)(BK * 2);
    const unsigned hstep = (unsigned)HALF * (unsigned)KB;
    const unsigned ldsw = (unsigned)wid * 1024u;
    const int aoff = lds_byte(wr * 64 + fr, fq * 8), boff = lds_byte(wc * 32 + fr, fq * 8);
    const __amdgpu_buffer_rsrc_t rA = __builtin_amdgcn_make_buffer_rsrc((void*)Abase, 0, 0xffffffff, 0x00020000);
    const __amdgpu_buffer_rsrc_t rB = __builtin_amdgcn_make_buffer_rsrc((void*)S.bbase(), 0, 0xffffffff, 0x00020000);
#define PG8_SA(b, h) (((b) * 2 + (h)) * HTB)
#define PG8_SB(b, h) ((4 + (b) * 2 + (h)) * HTB)
#define PG8_STAGEB(bufoff, soff) do { _Pragma("unroll") for (int _i = 0; _i < 2; ++_i) \
        __builtin_amdgcn_raw_ptr_buffer_load_lds(rB, (LAS unsigned*)(lds + (bufoff) + ldsw + _i * 8192), 16, voffB[_i], (soff), 0, 0); } while (0)
#define PG8_STAGEA(bufoff, offs, soff) do { _Pragma("unroll") for (int _i = 0; _i < 2; ++_i) \
        __builtin_amdgcn_raw_ptr_buffer_load_lds(rA, (LAS unsigned*)(lds + (bufoff) + ldsw + _i * 8192), 16, (offs)[_i], (soff), 0, 0); } while (0)
#define PG8_LDA(dst, b, h) do { _Pragma("unroll") for (int m = 0; m < 4; ++m) _Pragma("unroll") for (int k = 0; k < 2; ++k) dst[m][k] = *(const LAS bf16x8*)(lds + PG8_SA(b, h) + aoff + m * 2048 + k * 1024); } while (0)
#define PG8_LDB(dst, b, h) do { _Pragma("unroll") for (int n = 0; n < 2; ++n) _Pragma("unroll") for (int k = 0; k < 2; ++k) dst[n][k] = *(const LAS bf16x8*)(lds + PG8_SB(b, h) + boff + n * 2048 + k * 1024); } while (0)
#define PG8_CAT(x) __builtin_shufflevector(__builtin_bit_cast(u32x4, (x)[0]), __builtin_bit_cast(u32x4, (x)[1]), 0, 1, 2, 3, 4, 5, 6, 7)
#define PG8_MMA(ai, bj, At, Bt) do { __builtin_amdgcn_s_setprio(1); \
        if constexpr (Epi::FP8) { _Pragma("unroll") for (int m = 0; m < 4; ++m) _Pragma("unroll") for (int n = 0; n < 2; ++n) \
            { const i32x8 b8_ = __builtin_bit_cast(i32x8, PG8_CAT(Bt[n])), a8_ = __builtin_bit_cast(i32x8, PG8_CAT(At[m])); \
              asm volatile("v_mfma_f32_16x16x128_f8f6f4 %0, %1, %2, %0" : "+v"(acc[ai][bj][m][n]) : "v"(b8_), "v"(a8_)); } } \
        else { _Pragma("unroll") for (int m = 0; m < 4; ++m) _Pragma("unroll") for (int n = 0; n < 2; ++n) _Pragma("unroll") for (int k = 0; k < 2; ++k) \
            acc[ai][bj][m][n] = __builtin_amdgcn_mfma_f32_16x16x32_bf16(Bt[n][k], At[m][k], acc[ai][bj][m][n], 0, 0, 0); } \
        __builtin_amdgcn_s_setprio(0); } while (0)
#define PG8_WAIT_V(n) asm volatile("s_waitcnt vmcnt(" #n ")" ::: "memory")
#define PG8_WAIT_L(n) asm volatile("s_waitcnt lgkmcnt(" #n ")" ::: "memory")
#define PG8_BAR __builtin_amdgcn_s_barrier()
#define PG8_SCHED __builtin_amdgcn_sched_barrier(0)
#define PG8_KPAIR(K1, A20, A21, KA2, B2) do { \
            PG8_LDB(B0, 0, 0); PG8_LDB(B1, 0, 1); PG8_SCHED; PG8_LDA(At, 0, 0); PG8_STAGEA(PG8_SA(1, 1), ca1, (K1)); \
            PG8_WAIT_V(8); PG8_WAIT_L(0); PG8_BAR; PG8_MMA(0, 0, At, B0); PG8_MMA(0, 1, At, B1); PG8_BAR; PG8_SCHED; \
            PG8_LDA(At, 0, 1); PG8_STAGEB(PG8_SB(0, 0), (B2)); PG8_STAGEB(PG8_SB(0, 1), (B2) + hstep); PG8_STAGEA(PG8_SA(0, 0), A20, (KA2)); \
            PG8_WAIT_V(8); PG8_WAIT_L(0); PG8_BAR; PG8_MMA(1, 0, At, B0); PG8_MMA(1, 1, At, B1); PG8_BAR; PG8_SCHED; \
            PG8_LDB(B0, 1, 0); PG8_LDB(B1, 1, 1); PG8_SCHED; PG8_LDA(At, 1, 0); PG8_STAGEA(PG8_SA(0, 1), A21, (KA2)); \
            PG8_WAIT_V(8); PG8_WAIT_L(0); PG8_BAR; PG8_MMA(0, 0, At, B0); PG8_MMA(0, 1, At, B1); PG8_BAR; PG8_SCHED; \
            PG8_LDA(At, 1, 1); PG8_STAGEB(PG8_SB(1, 0), (B2) + kstep); PG8_STAGEB(PG8_SB(1, 1), (B2) + kstep + hstep); PG8_STAGEA(PG8_SA(1, 0), A20, (KA2) + kstep); \
            PG8_WAIT_V(8); PG8_WAIT_L(0); PG8_BAR; PG8_MMA(1, 0, At, B0); PG8_MMA(1, 1, At, B1); PG8_BAR; PG8_SCHED; } while (0)
    Unit cur, nxt; int ui = 0;
    if (!S.next(0, cur)) return;
    f32x4 acc[2][2][4][2];
#pragma unroll
    for (int a = 0; a < 2; ++a)
#pragma unroll
        for (int b = 0; b < 2; ++b)
#pragma unroll
            for (int m = 0; m < 4; ++m)
#pragma unroll
                for (int n = 0; n < 2; ++n) acc[a][b][m][n] = (f32x4){0.f, 0.f, 0.f, 0.f};
    bf16x8 At[4][2], B0[2][2], B1[2][2];
    unsigned ca0[2], ca1[2], na0[2], na1[2];
#pragma unroll
    for (int i = 0; i < 2; ++i) { ca0[i] = S.aoff(0, cur, Rr[i]) + colA[i]; ca1[i] = S.aoff(0, cur, HALF + Rr[i]) + colA[i]; }
    unsigned cB = S.boff(cur);
    PG8_STAGEB(PG8_SB(0, 0), cB); PG8_STAGEB(PG8_SB(0, 1), cB + hstep); PG8_STAGEA(PG8_SA(0, 0), ca0, 0u); PG8_STAGEA(PG8_SA(0, 1), ca1, 0u);
    if (wr == 1) PG8_BAR;
    PG8_WAIT_V(2); PG8_BAR;
    PG8_STAGEB(PG8_SB(1, 0), cB + kstep); PG8_STAGEA(PG8_SA(1, 0), ca0, kstep); PG8_STAGEB(PG8_SB(1, 1), cB + hstep + kstep);
    PG8_WAIT_V(6); PG8_BAR;
    for (;;) {
        const bool has_next = S.next(ui + 1, nxt);
        const unsigned nB = has_next ? S.boff(nxt) : cB;
#pragma unroll
        for (int i = 0; i < 2; ++i) { na0[i] = has_next ? S.aoff(ui + 1, nxt, Rr[i]) + colA[i] : ca0[i]; na1[i] = has_next ? S.aoff(ui + 1, nxt, HALF + Rr[i]) + colA[i] : ca1[i]; }
#pragma unroll 1
        for (int t = 0; t < nt - 2; t += 2) { const unsigned k1 = (unsigned)(t + 1) * kstep, k2 = (unsigned)(t + 2) * kstep; PG8_KPAIR(k1, ca0, ca1, k2, cB + k2); }
        { const unsigned k1 = (unsigned)(nt - 1) * kstep; PG8_KPAIR(k1, na0, na1, 0u, nB); }
        if (wr == 0) PG8_BAR;
        if constexpr (Epi::FP8) asm volatile("s_nop 15\n\ts_nop 7" ::: "memory");
        E(acc, cur, wr, wc, fr, fq);
        if (!has_next) break;
#pragma unroll
        for (int a = 0; a < 2; ++a)
#pragma unroll
            for (int b = 0; b < 2; ++b)
#pragma unroll
                for (int m = 0; m < 4; ++m)
#pragma unroll
                    for (int n = 0; n < 2; ++n) acc[a][b][m][n] = (f32x4){0.f, 0.f, 0.f, 0.f};
        cur = nxt; cB = nB; ++ui;
#pragma unroll
        for (int i = 0; i < 2; ++i) { ca0[i] = na0[i]; ca1[i] = na1[i]; }
        if (wr == 1) PG8_BAR;
    }
    PG8_WAIT_V(0);
    PG8_BAR;
#undef PG8_KPAIR
#undef PG8_CAT
#undef PG8_SA
#undef PG8_SB
#undef PG8_STAGEA
#undef PG8_STAGEB
#undef PG8_LDA
#undef PG8_LDB
#undef PG8_MMA
#undef PG8_WAIT_V
#undef PG8_WAIT_L
#undef PG8_BAR
#undef PG8_SCHED
}

struct EpiIn {
    static constexpr bool PERM = true, FP8 = false;
    bf16 *Q, *Kh, *VT, *HCV; const float *qg, *kg;
    __device__ __forceinline__ void operator()(const f32x4 (&acc)[2][2][4][2], const Unit& u, int wr, int wc, int fr, int fq) const {
        const int pn = u.pn;
        const int row0 = u.pm * BM + wr * 64 + fr;
        if (pn < 4) {
            const bool isq = pn < 2; const float* g = isq ? qg : kg; const float sc = isq ? QSCALE : 1.0f;
            const int head = 4 * (pn & 1) + wc;
            f32x4 gv[2][2];
#pragma unroll
            for (int bj = 0; bj < 2; ++bj)
#pragma unroll
                for (int n = 0; n < 2; ++n) gv[bj][n] = *(const f32x4*)(g + 32 * bj + 8 * fq + 4 * n) * sc;
#pragma unroll
            for (int ai = 0; ai < 2; ++ai)
#pragma unroll
                for (int m = 0; m < 4; ++m) {
                    float ss = 0.f;
#pragma unroll
                    for (int bj = 0; bj < 2; ++bj)
#pragma unroll
                        for (int n = 0; n < 2; ++n) { const f32x4 x = acc[ai][bj][m][n]; ss += (x[0] * x[0] + x[1] * x[1]) + (x[2] * x[2] + x[3] * x[3]); }
                    ss += __shfl_xor(ss, 16); ss += __shfl_xor(ss, 32);
                    const float rs = __builtin_amdgcn_rsqf(ss * (1.0f / 64.0f) + EPS);
                    const int row = row0 + ai * HALF + m * 16, b = row >> 12, t = row & 4095;
                    bf16* dst = isq ? Q + ((size_t)(b * NH + head) * SEQ + t) * HD : Kh + ((size_t)(b * NH + head) * LP + 32 + t) * HD;
#pragma unroll
                    for (int bj = 0; bj < 2; ++bj) { const f32x4 v0 = acc[ai][bj][m][0] * rs * gv[bj][0], v1 = acc[ai][bj][m][1] * rs * gv[bj][1];
                        u32x4 w; w.x = cvt_pk_bf16(v0[0], v0[1]); w.y = cvt_pk_bf16(v0[2], v0[3]); w.z = cvt_pk_bf16(v1[0], v1[1]); w.w = cvt_pk_bf16(v1[2], v1[3]);
                        *(u32x4*)(dst + 32 * bj + 8 * fq) = w; }
                }
        } else if (pn < 6) {
            const int head = 4 * (pn & 1) + wc;
#pragma unroll
            for (int ai = 0; ai < 2; ++ai)
#pragma unroll
                for (int m = 0; m < 4; ++m) {
                    const int row = row0 + ai * HALF + m * 16, b = row >> 12, t = row & 4095;
                    bf16* dst = VT + ((size_t)(b * NH + head) * HD) * LP + 32 + t;
#pragma unroll
                    for (int bj = 0; bj < 2; ++bj)
#pragma unroll
                        for (int n = 0; n < 2; ++n)
#pragma unroll
                            for (int e = 0; e < 4; ++e) dst[(size_t)(32 * bj + 8 * fq + 4 * n + e) * LP] = f2bf(acc[ai][bj][m][n][e]);
                }
        } else {
            const int ch0 = 128 * (pn - 6) + 32 * wc + 8 * fq;
#pragma unroll
            for (int ai = 0; ai < 2; ++ai)
#pragma unroll
                for (int m = 0; m < 4; ++m) {
                    const int row = row0 + ai * HALF + m * 16, b = row >> 12, t = row & 4095;
                    f32x4 h0, h1;
#pragma unroll
                    for (int e = 0; e < 4; ++e) { h0[e] = acc[ai][0][m][0][e] * sigmoidf_(acc[ai][1][m][0][e]); h1[e] = acc[ai][0][m][1][e] * sigmoidf_(acc[ai][1][m][1][e]); }
                    u32x4 w; w.x = cvt_pk_bf16(h0[0], h0[1]); w.y = cvt_pk_bf16(h0[2], h0[3]); w.z = cvt_pk_bf16(h1[0], h1[1]); w.w = cvt_pk_bf16(h1[2], h1[3]);
                    *(u32x4*)(HCV + ((size_t)b * LP + 32 + t) * CW + ch0) = w;
                }
        }
    }
};
struct EpiRes {
    static constexpr bool PERM = false, FP8 = false;
    const float* X; float* O;
    __device__ __forceinline__ void operator()(const f32x4 (&acc)[2][2][4][2], const Unit& u, int wr, int wc, int fr, int fq) const {
        const int row0 = u.pm * BM + wr * 64 + fr, col0 = u.pn * BM + wc * 32 + 4 * fq;
#pragma unroll
        for (int ai = 0; ai < 2; ++ai)
#pragma unroll
            for (int m = 0; m < 4; ++m) { const size_t off = (size_t)(row0 + ai * HALF + m * 16) * DM + col0;
#pragma unroll
                for (int bj = 0; bj < 2; ++bj)
#pragma unroll
                    for (int n = 0; n < 2; ++n) { const f32x4 xv = *(const f32x4*)(X + off + bj * HALF + n * 16); *(f32x4*)(O + off + bj * HALF + n * 16) = xv + acc[ai][bj][m][n]; } }
    }
};
struct EpiUp {
    static constexpr bool PERM = true, FP8 = true;
    unsigned char* ACT; const float* bup;
    __device__ __forceinline__ void operator()(const f32x4 (&acc)[2][2][4][2], const Unit& u, int wr, int wc, int fr, int fq) const {
        const int c0 = 128 * u.pn + 32 * wc + 8 * fq;
        const float* bb = bup + (size_t)u.e * 2048 + c0;
        const f32x4 bg0 = *(const f32x4*)(bb), bg1 = *(const f32x4*)(bb + 4), bl0 = *(const f32x4*)(bb + 1024), bl1 = *(const f32x4*)(bb + 1028);
        const int row0 = u.pm * BM + wr * 64 + fr;
#pragma unroll
        for (int ai = 0; ai < 2; ++ai)
#pragma unroll
            for (int m = 0; m < 4; ++m) {
                constexpr float dq = 1.0f / (SC_HN * SC_W);
                const f32x4 g0 = acc[ai][0][m][0] * dq + bg0, g1 = acc[ai][0][m][1] * dq + bg1, l0 = acc[ai][1][m][0] * dq + bl0, l1 = acc[ai][1][m][1] * dq + bl1;
                f32x4 a0, a1;
#pragma unroll
                for (int e = 0; e < 4; ++e) {
                    const float ga = fminf(g0[e], SW_LIMIT), la = fminf(fmaxf(l0[e], -SW_LIMIT), SW_LIMIT); a0[e] = ga * sigmoidf_(SW_ALPHA * ga) * (la + 1.0f);
                    const float gb = fminf(g1[e], SW_LIMIT), lb = fminf(fmaxf(l1[e], -SW_LIMIT), SW_LIMIT); a1[e] = gb * sigmoidf_(SW_ALPHA * gb) * (lb + 1.0f); }
                u32x2 w; w.x = pack4_fp8(a0[0] * SC_ACT, a0[1] * SC_ACT, a0[2] * SC_ACT, a0[3] * SC_ACT); w.y = pack4_fp8(a1[0] * SC_ACT, a1[1] * SC_ACT, a1[2] * SC_ACT, a1[3] * SC_ACT);
                *(u32x2*)(ACT + (size_t)(row0 + ai * HALF + m * 16) * DE + c0) = w;
            }
    }
};
struct EpiDown {
    static constexpr bool PERM = true, FP8 = true;
    bf16* Y; const float* bdn; const float* rgate;
    __device__ __forceinline__ void operator()(const f32x4 (&acc)[2][2][4][2], const Unit& u, int wr, int wc, int fr, int fq) const {
        const int c0 = u.pn * BM + wc * 32 + 8 * fq;
        const float* bb = bdn + (size_t)u.e * DM + c0;
        f32x4 bv[2][2];
#pragma unroll
        for (int bj = 0; bj < 2; ++bj)
#pragma unroll
            for (int n = 0; n < 2; ++n) bv[bj][n] = *(const f32x4*)(bb + bj * HALF + 4 * n);
        const int lrow0 = wr * 64 + fr;
        const float* gp = rgate + (size_t)u.e * CAP + u.rt * BM;
#pragma unroll
        for (int ai = 0; ai < 2; ++ai)
#pragma unroll
            for (int m = 0; m < 4; ++m) {
                const int lr = lrow0 + ai * HALF + m * 16; const float gt = gp[lr];
                bf16* rowp = Y + (size_t)(u.pm * BM + lr) * DM + c0;
#pragma unroll
                for (int bj = 0; bj < 2; ++bj) { constexpr float dq = 1.0f / (SC_ACT * SC_W); const f32x4 v0 = (acc[ai][bj][m][0] * dq + bv[bj][0]) * gt, v1 = (acc[ai][bj][m][1] * dq + bv[bj][1]) * gt;
                    u32x4 w; w.x = cvt_pk_bf16(v0[0], v0[1]); w.y = cvt_pk_bf16(v0[2], v0[3]); w.z = cvt_pk_bf16(v1[0], v1[1]); w.w = cvt_pk_bf16(v1[2], v1[3]);
                    *(u32x4*)(rowp + bj * HALF) = w; }
            }
    }
};
}

struct Frame {
    LAS unsigned char* lds; LAS unsigned char* aux;
    gu32* ctl;
    int tid, lane, wave, vcu, G;
    const float *x, *meta, *g1, *w_in, *qg, *kg, *conv_w, *conv_b, *ln_g, *ln_b, *og, *w_out, *g2, *w_r, *b_r, *w_up, *b_up, *w_dn, *b_dn;
    float* out;
    bf16 *WinT, *WoT, *NM, *Q, *Kh, *VT, *HCV, *Y;
    unsigned char *WdT, *WupT, *HN, *ACT;
    int* rtok; float* rgate; unsigned* tslot;
};

__device__ __forceinline__ int win_dest(int n0) {
    if (n0 < 1536) { const int tile = n0 >> 8, s = n0 & 255, wc = s >> 6, bj = (s >> 5) & 1; return tile * 256 + 128 * bj + 32 * wc; }
    if (n0 < 2048) { const int j = n0 - 1536; return 1536 + 256 * (j >> 7) + (j & 127); }
    const int j = n0 - 2048; return 1536 + 256 * (j >> 7) + 128 + (j & 127);
}
__device__ __forceinline__ int wup_dest(int n0) { if (n0 < 1024) return 256 * (n0 >> 7) + (n0 & 127); const int j = n0 - 1024; return 256 * (j >> 7) + 128 + (j & 127); }
struct TrItem { const float* src; const float* g; void* dst; int N; int f8; };
__device__ __forceinline__ void tr_load(const TrItem& t, f32x4 (&v)[8], float (&gv)[8], int lane) {
    const int kr = lane >> 3, nc = (lane & 7) * 4;
#pragma unroll
    for (int i = 0; i < 8; ++i) { v[i] = *(const f32x4*)(t.src + (size_t)(8 * i + kr) * t.N + nc); gv[i] = t.g ? t.g[8 * i + kr] : 1.0f; }
}
__device__ __forceinline__ void tr_store(const TrItem& t, const f32x4 (&v)[8], const float (&gv)[8], LAS float* scr, int lane) {
    const int kr = lane >> 3, nc = (lane & 7) * 4;
#pragma unroll
    for (int i = 0; i < 8; ++i) { LAS float* d = scr + (8 * i + kr) * 33 + nc; d[0] = v[i].x * gv[i]; d[1] = v[i].y * gv[i]; d[2] = v[i].z * gv[i]; d[3] = v[i].w * gv[i]; }
    LDS_WAIT(); asm volatile("" ::: "memory");
    const int c = lane & 7;
#pragma unroll
    for (int j = 0; j < 4; ++j) { const int n = (lane >> 3) + 8 * j; const LAS float* q = scr + (8 * c) * 33 + n;
        if (t.f8) { u32x2 o; o.x = pack4_fp8(q[0 * 33] * SC_W, q[1 * 33] * SC_W, q[2 * 33] * SC_W, q[3 * 33] * SC_W); o.y = pack4_fp8(q[4 * 33] * SC_W, q[5 * 33] * SC_W, q[6 * 33] * SC_W, q[7 * 33] * SC_W);
            *(u32x2*)((unsigned char*)t.dst + (size_t)n * 1024 + 8 * c) = o; }
        else { u32x4 o; o.x = cvt_pk_bf16(q[0 * 33], q[1 * 33]); o.y = cvt_pk_bf16(q[2 * 33], q[3 * 33]); o.z = cvt_pk_bf16(q[4 * 33], q[5 * 33]); o.w = cvt_pk_bf16(q[6 * 33], q[7 * 33]);
            *(u32x4*)((bf16*)t.dst + (size_t)n * 1024 + 8 * c) = o; } }
    LDS_WAIT(); asm volatile("" ::: "memory");
}
__device__ __forceinline__ void meta_unit(Frame& F, int mu) {
    LAS float* nmT = (LAS float*)F.lds;
    LAS float* part = (LAS float*)(F.lds + 65536);
    LAS float* rs = (LAS float*)(F.aux + A_RED);
    const int type = mu >> 3, hh = mu & 7, lane = F.lane, w = F.wave;
    for (int r = 2 * w; r < 2 * w + 2; ++r) { float s = 0.f; for (int k = lane; k < DM; k += 64) { const float v = F.meta[r * DM + k]; s += v * v; } s = wave_sum(s); if (lane == 0) rs[r] = __builtin_amdgcn_rsqf(s * (1.0f / DM) + EPS); }
    __syncthreads();
    for (int idx = F.tid; idx < NMETA * DM; idx += 512) { const int r = idx >> 10, k = idx & 1023; nmT[k * 16 + r] = F.meta[idx] * rs[r] * F.g1[k]; }
    __syncthreads();
    const int col = (type == 0 ? 512 : type == 1 ? 1024 : 1536) + 64 * hh + lane, colg = 2048 + 64 * hh + lane;
    float a1[16], a2[16];
#pragma unroll
    for (int r = 0; r < 16; ++r) { a1[r] = 0.f; a2[r] = 0.f; }
    for (int k0 = 128 * w; k0 < 128 * w + 128; k0 += 16) {
        float wv[16], wg[16];
#pragma unroll
        for (int i = 0; i < 16; ++i) { wv[i] = F.w_in[(size_t)(k0 + i) * INC + col]; wg[i] = (type == 2) ? F.w_in[(size_t)(k0 + i) * INC + colg] : 0.f; }
#pragma unroll
        for (int i = 0; i < 16; ++i) {
            const LAS f32x4* np = (const LAS f32x4*)(nmT + (k0 + i) * 16);
#pragma unroll
            for (int q = 0; q < 4; ++q) { const f32x4 nv = np[q];
#pragma unroll
                for (int e = 0; e < 4; ++e) { a1[4 * q + e] += nv[e] * wv[i]; a2[4 * q + e] += nv[e] * wg[i]; } }
        }
    }
#pragma unroll
    for (int r = 0; r < 16; ++r) { part[(w * 16 + r) * 64 + lane] = a1[r]; part[8192 + (w * 16 + r) * 64 + lane] = a2[r]; }
    __syncthreads();
    for (int r = 2 * w; r < 2 * w + 2; ++r) {
        float v = 0.f, v2 = 0.f;
#pragma unroll
        for (int ww = 0; ww < 8; ++ww) { v += part[(ww * 16 + r) * 64 + lane]; v2 += part[8192 + (ww * 16 + r) * 64 + lane]; }
        if (type == 0) { const float ss = wave_sum(v * v); const bf16 o = f2bf(v * __builtin_amdgcn_rsqf(ss * (1.0f / 64.0f) + EPS) * F.kg[lane]);
            for (int b = 0; b < NB; ++b) F.Kh[((size_t)(b * NH + hh) * LP + LPAD + r) * HD + lane] = o; }
        else if (type == 1) { const bf16 o = f2bf(v); for (int b = 0; b < NB; ++b) F.VT[((size_t)(b * NH + hh) * HD + lane) * LP + LPAD + r] = o; }
        else { const bf16 o = f2bf(v * sigmoidf_(v2)); for (int b = 0; b < NB; ++b) F.HCV[((size_t)b * LP + LPAD + r) * CW + 64 * hh + lane] = o; }
    }
    __syncthreads();
}
template <int PARTS> __device__ __forceinline__ void p0_prologue(Frame& F) {
    if (PARTS & 1) { if (F.vcu < 24) meta_unit(F, F.vcu);
    for (int mu = F.vcu + F.G; mu < 24; mu += F.G) meta_unit(F, mu); }
    LAS float* scr = (LAS float*)(F.lds + F.wave * 16384);
    const int gw = F.vcu * NWAVES + F.wave, NGW = F.G * NWAVES, lane = F.lane;
    if (PARTS & 1) for (int it = gw; it < 192; it += NGW) {
        const u32x4 z = (u32x4){0u, 0u, 0u, 0u};
        if (it < 64) { u32x4* p = (u32x4*)(F.Kh + (size_t)it * LP * HD); p[lane] = z; p[64 + lane] = z; }
        else if (it < 128) { u32x4* p = (u32x4*)(F.VT + ((size_t)(it - 64) * HD + lane) * LP); p[0] = z; p[1] = z; }
        else { const int j = it - 128, b = j >> 3, rr = (j & 7) * 2; u32x4* p = (u32x4*)(F.HCV + ((size_t)b * LP + rr) * CW); p[lane] = z; p[64 + lane] = z; }
    }
    constexpr int I_IN = 16 * 80, I_O = 16 * 32, I_UP = NE * 16 * 64, I_DN = NE * 16 * 32, NITEMS = I_IN + I_O + I_UP + I_DN;
    auto decode = [&](int it, TrItem& t) {
        int r = it;
        if (r < I_IN) { const int kb = r / 80, nb = r % 80; t.src = F.w_in + (size_t)(64 * kb) * INC + 32 * nb; t.N = INC; t.g = F.g1 + 64 * kb; t.dst = F.WinT + (size_t)win_dest(32 * nb) * 1024 + 64 * kb; t.f8 = 0; return; } r -= I_IN;
        if (r < I_O) { const int kb = r / 32, nb = r % 32; t.src = F.w_out + (size_t)(64 * kb) * DM + 32 * nb; t.N = DM; t.g = nullptr; t.dst = F.WoT + (size_t)(32 * nb) * 1024 + 64 * kb; t.f8 = 0; return; } r -= I_O;
        if (r < I_UP) { const int e = r >> 10, rr = r & 1023, kb = rr >> 6, nb = rr & 63; t.src = F.w_up + (size_t)e * DM * 2048 + (size_t)(64 * kb) * 2048 + 32 * nb; t.N = 2048; t.g = F.g2 + 64 * kb;
            t.dst = F.WupT + ((size_t)e * 2048 + wup_dest(32 * nb)) * 1024 + 64 * kb; t.f8 = 1; return; } r -= I_UP;
        { const int e = r >> 9, rr = r & 511, kb = rr >> 5, nb = rr & 31; t.src = F.w_dn + (size_t)e * DE * DM + (size_t)(64 * kb) * DM + 32 * nb; t.N = DM; t.g = nullptr;
            t.dst = F.WdT + ((size_t)e * DM + 32 * nb) * 1024 + 64 * kb; t.f8 = 1; }
    };
    if (PARTS & 2) {
        constexpr int META_CREDIT = 4;
        const int nmw = (F.G > 24 ? 24 : 0) * NWAVES, N1 = NITEMS - META_CREDIT * nmw, q1 = (N1 - gw + NGW - 1) / NGW;
        auto seq = [&](int q) -> int { if (q < q1) return gw + q * NGW; if (gw < nmw) return NITEMS; return N1 + (gw - nmw) + (q - q1) * (NGW - nmw); };
        TrItem t0, t1, t2; f32x4 va[8], vb[8], vc[8]; float ga[8], gb[8], gc[8];
        int q = 0, i0 = seq(0), i1 = seq(1);
        if (i0 < NITEMS) { decode(i0, t0); tr_load(t0, va, ga, lane); }
        if (i1 < NITEMS) { decode(i1, t1); tr_load(t1, vb, gb, lane); }
        while (i0 < NITEMS) {
            const int i2 = seq(q + 2);
            if (i2 < NITEMS) { decode(i2, t2); tr_load(t2, vc, gc, lane); }
            tr_store(t0, va, ga, scr, lane);
            t0 = t1; t1 = t2; i0 = i1; i1 = i2; ++q;
#pragma unroll
            for (int i = 0; i < 8; ++i) { va[i] = vb[i]; ga[i] = gb[i]; vb[i] = vc[i]; gb[i] = gc[i]; }
        }
    }
    if (PARTS & 4) for (int m = gw; m < NTOK; m += 4 * NGW) {
        f32x4 v[4][4]; float ss[4];
#pragma unroll
        for (int r = 0; r < 4; ++r) { const int mr = (m + r * NGW < NTOK) ? m + r * NGW : m; const f32x4* xr = (const f32x4*)(F.x + (size_t)mr * DM) + lane;
#pragma unroll
            for (int j = 0; j < 4; ++j) v[r][j] = xr[64 * j]; }
#pragma unroll
        for (int r = 0; r < 4; ++r) { float q = 0.f;
#pragma unroll
            for (int j = 0; j < 4; ++j) q += (v[r][j].x * v[r][j].x + v[r][j].y * v[r][j].y) + (v[r][j].z * v[r][j].z + v[r][j].w * v[r][j].w);
            ss[r] = __builtin_amdgcn_rsqf(wave_sum(q) * (1.0f / DM) + EPS); }
#pragma unroll
        for (int r = 0; r < 4; ++r) { const int mr = (m + r * NGW < NTOK) ? m + r * NGW : m; u32x2* o8 = (u32x2*)(F.NM + (size_t)mr * DM) + lane;
#pragma unroll
            for (int j = 0; j < 4; ++j) { u32x2 o; o.x = cvt_pk_bf16(v[r][j].x * ss[r], v[r][j].y * ss[r]); o.y = cvt_pk_bf16(v[r][j].z * ss[r], v[r][j].w * ss[r]); o8[64 * j] = o; } }
    }
}

__device__ __forceinline__ void conv_phase(Frame& F) {
    const int c = F.tid, lane = F.lane;
    LAS float* red = (LAS float*)(F.aux + A_RED); LAS float* tot = (LAS float*)(F.aux + A_TOT);
    float w[CKW];
#pragma unroll
    for (int j = 0; j < CKW; ++j) w[j] = F.conv_w[j * CW + c];
    const float cb = F.conv_b[c], lg = F.ln_g[c], lb = F.ln_b[c];
    for (int u = F.vcu; u < NTOK / 16; u += F.G) {
        const int t0 = u * 16, b = t0 >> 12, tb = t0 & 4095;
        const bf16* hp = F.HCV + ((size_t)b * LP + tb + 2) * CW + c;
        float h[46];
#pragma unroll
        for (int i = 0; i < 46; ++i) h[i] = bf2f(hp[(size_t)i * CW]);
        float v[16], rr[32];
#pragma unroll
        for (int j = 0; j < 16; ++j) { float s = cb;
#pragma unroll
            for (int k = 0; k < CKW; ++k) s += w[k] * h[j + k];
            v[j] = s; rr[j] = s; rr[16 + j] = s * s; }
        wave_reduce32(rr);
        if ((lane & 15) == 0) {
#pragma unroll
            for (int i = 0; i < 8; ++i) red[F.wave * 32 + 8 * (lane >> 4) + i] = rr[i]; }
        __syncthreads();
        if (F.tid < 32) { float s = 0.f;
#pragma unroll
            for (int ww = 0; ww < 8; ++ww) s += red[ww * 32 + F.tid]; tot[F.tid] = s; }
        __syncthreads();
#pragma unroll
        for (int j = 0; j < 16; ++j) { const float mean = tot[j] * (1.0f / CW), var = fmaxf(tot[16 + j] * (1.0f / CW) - mean * mean, 0.f);
            const float y = (v[j] - mean) * __builtin_amdgcn_rsqf(var + EPS) * lg + lb;
            F.NM[(size_t)(t0 + j) * DM + SBW + c] = f2bf(y * sigmoidf_(y)); }
    }
}

template <bool EARLY>
__device__ __forceinline__ void attn_wave_unit(Frame& F, int bh, int qb, LAS float* stg) {
    const int lane = F.lane, r = lane & 31, hf = lane >> 5;
    const bf16* qp = F.Q + ((size_t)bh * SEQ + qb * 32 + r) * HD + 8 * hf;
    bf16x8 qf[4];
#pragma unroll
    for (int s = 0; s < 4; ++s) qf[s] = *(const bf16x8*)(qp + 16 * s);
    const int krow = (r & ~12) | ((r & 4) << 1) | ((r & 8) >> 1);
    const bf16* kp = F.Kh + ((size_t)bh * LP + krow) * HD + 8 * hf;
    const bf16* vp = F.VT + ((size_t)bh * HD + r) * LP + 8 * hf;
    f32x16 o0, o1;
#pragma unroll
    for (int i = 0; i < 16; ++i) { o0[i] = 0.f; o1[i] = 0.f; }
    float C = 1.0f;
    int jb = qb + 1;
    bf16x8 kf[4], vf[4], kn[4], vn[4];
#define LOADKV(KF, VF, J) do { _Pragma("unroll") for (int s = 0; s < 4; ++s) KF[s] = *(const bf16x8*)(kp + (size_t)(J) * 32 * HD + 16 * s); \
        _Pragma("unroll") for (int d = 0; d < 2; ++d) _Pragma("unroll") for (int s = 0; s < 2; ++s) VF[d * 2 + s] = *(const bf16x8*)(vp + (size_t)d * 32 * LP + (J) * 32 + 16 * s); } while (0)
    LOADKV(kf, vf, jb);
    for (;;) {
        const int jn = jb > 0 ? jb - 1 : 0;
        LOADKV(kn, vn, jn);
        f32x16 st;
#pragma unroll
        for (int i = 0; i < 16; ++i) st[i] = 0.f;
#pragma unroll
        for (int s = 0; s < 4; ++s) st = __builtin_amdgcn_mfma_f32_32x32x16_bf16(kf[s], qf[s], st, 0, 0, 0);
        const bool diag = (jb == qb + 1), first = (jb == 0);
        float be[16], ke[16];
#pragma unroll
        for (int i = 0; i < 16; ++i) {
            const int c = 16 * (i >> 3) + 8 * hf + (i & 7);
            const float u = fast_exp2(-st[i]);
            const float bt = fast_rcp(1.0f + u);
            const bool valid = diag ? (c < r) : (first ? (c >= 16) : true);
            be[i] = valid ? bt : 0.f; ke[i] = valid ? u * bt : 1.0f;
        }
        float plo = ke[0], phi = ke[8];
#pragma unroll
        for (int i = 1; i < 8; ++i) { plo *= ke[i]; phi *= ke[8 + i]; }
        const float plo_o = __shfl_xor(plo, 32), phi_o = __shfl_xor(phi, 32);
        const float X1 = phi * phi_o, X0 = plo * plo_o, CX1 = C * X1;
        float run = hf ? C : C * phi_o;
        float a[16];
#pragma unroll
        for (int i = 15; i >= 8; --i) { a[i] = be[i] * run; run *= ke[i]; }
        run = hf ? CX1 : CX1 * plo_o;
#pragma unroll
        for (int i = 7; i >= 0; --i) { a[i] = be[i] * run; run *= ke[i]; }
        C = CX1 * X0;
        u32x4 p0, p1;
        p0.x = cvt_pk_bf16(a[0], a[1]); p0.y = cvt_pk_bf16(a[2], a[3]); p0.z = cvt_pk_bf16(a[4], a[5]); p0.w = cvt_pk_bf16(a[6], a[7]);
        p1.x = cvt_pk_bf16(a[8], a[9]); p1.y = cvt_pk_bf16(a[10], a[11]); p1.z = cvt_pk_bf16(a[12], a[13]); p1.w = cvt_pk_bf16(a[14], a[15]);
        const bf16x8 af0 = __builtin_bit_cast(bf16x8, p0), af1 = __builtin_bit_cast(bf16x8, p1);
        o0 = __builtin_amdgcn_mfma_f32_32x32x16_bf16(af0, vf[0], o0, 0, 0, 0); o0 = __builtin_amdgcn_mfma_f32_32x32x16_bf16(af1, vf[1], o0, 0, 0, 0);
        o1 = __builtin_amdgcn_mfma_f32_32x32x16_bf16(af0, vf[2], o1, 0, 0, 0); o1 = __builtin_amdgcn_mfma_f32_32x32x16_bf16(af1, vf[3], o1, 0, 0, 0);
        if (jb == 0) break;
        if (EARLY) { if (__all(C < ATTN_CUT)) break; }
        --jb;
#pragma unroll
        for (int s = 0; s < 4; ++s) { kf[s] = kn[s]; vf[s] = vn[s]; }
    }
#undef LOADKV
#pragma unroll
    for (int i = 0; i < 16; ++i) { const int q = (i & 3) + 8 * (i >> 2) + 4 * hf; stg[q * 68 + r] = o0[i]; stg[q * 68 + 32 + r] = o1[i]; }
    LDS_WAIT(); asm volatile("" ::: "memory");
    const int q = lane >> 1, half = lane & 1, h = bh & 7, b = bh >> 3;
    f32x4 v[8]; float ss = 0.f;
#pragma unroll
    for (int j = 0; j < 8; ++j) { v[j] = *(const LAS f32x4*)(stg + q * 68 + 32 * half + 4 * j); ss += (v[j].x * v[j].x + v[j].y * v[j].y) + (v[j].z * v[j].z + v[j].w * v[j].w); }
    ss += __shfl_xor(ss, 1);
    const float rstd = __builtin_amdgcn_rsqf(ss * (1.0f / 64.0f) + EPS);
    const float* gp = F.og + h * HD + 32 * half;
    bf16* dst = F.NM + ((size_t)(b * SEQ + qb * 32 + q)) * DM + h * HD + 32 * half;
#pragma unroll
    for (int j = 0; j < 4; ++j) { const f32x4 g0 = *(const f32x4*)(gp + 8 * j), g1 = *(const f32x4*)(gp + 8 * j + 4); const f32x4 a0 = v[2 * j] * rstd * g0, a1 = v[2 * j + 1] * rstd * g1;
        u32x4 w; w.x = cvt_pk_bf16(a0[0], a0[1]); w.y = cvt_pk_bf16(a0[2], a0[3]); w.z = cvt_pk_bf16(a1[0], a1[1]); w.w = cvt_pk_bf16(a1[2], a1[3]);
        *(u32x4*)(dst + 8 * j) = w; }
    LDS_WAIT(); asm volatile("" ::: "memory");
}
__device__ __forceinline__ void attn_phase(Frame& F) {
    LAS float* stg = (LAS float*)(F.lds + F.wave * 8704);
    for (int wu = F.vcu; wu < 64 * 16; wu += F.G) {
        const int bh = wu & 63, j = wu >> 6;
        const int i = j >> 2, j0 = j & 3;
        const int grp = (i == 0) ? j0 : (i == 1) ? 15 - j0 : (i == 2) ? 4 + j0 : 11 - j0;
        attn_wave_unit<ATTN_EARLY != 0>(F, bh, grp * 8 + F.wave, stg);
    }
}

template <int MODE> __device__ __forceinline__ void router_phase(Frame& F, const bool commit) {
    LAS float* Wt = (LAS float*)F.lds;
    LAS int* hist = (LAS int*)(F.aux + A_HIST); LAS int* base = (LAS int*)(F.aux + A_BASE);
    LAS int* sel_e = (LAS int*)(F.aux + A_SELE); LAS float* sel_g = (LAS float*)(F.aux + A_SELG); LAS int* rank = (LAS int*)(F.aux + A_RANK);
    const int lane = F.lane;
    if (!(MODE & 4)) {
#pragma unroll 8
    for (int idx = F.tid; idx < NE * DM; idx += 512) { const int k = idx >> 5, e = idx & 31; Wt[e * 1024 + k] = F.w_r[idx] * F.g2[k]; } }
    __syncthreads();
    const float br_me = F.b_r[lane >> 1];
    for (int blk = F.vcu; blk < NTOK / 128; blk += F.G) {
        if (F.tid < 32) hist[F.tid] = 0;
        f32x4 xn[4];
        { const f32x4* xr0 = (const f32x4*)(F.out + (size_t)(blk * 128 + F.wave * 16) * DM) + lane;
#pragma unroll
          for (int j = 0; j < 4; ++j) xn[j] = xr0[64 * j]; }
        for (int tl = F.wave * 16; tl < F.wave * 16 + 16; ++tl) {
            const int t = blk * 128 + tl;
            f32x4 xv[4]; float s = 0.f;
#pragma unroll
            for (int j = 0; j < 4; ++j) { xv[j] = xn[j]; s += (xv[j].x * xv[j].x + xv[j].y * xv[j].y) + (xv[j].z * xv[j].z + xv[j].w * xv[j].w); }
            { const int tn = (tl + 1 < F.wave * 16 + 16) ? t + 1 : t; const f32x4* xr1 = (const f32x4*)(F.out + (size_t)tn * DM) + lane;
#pragma unroll
              for (int j = 0; j < 4; ++j) xn[j] = xr1[64 * j]; }
            const float rstd = __builtin_amdgcn_rsqf(wave_sum(s) * (1.0f / DM) + EPS);
            unsigned* o8 = (unsigned*)(F.HN + (size_t)t * DM) + lane; const float rq = rstd * SC_HN;
#pragma unroll
            for (int j = 0; j < 4; ++j) o8[64 * j] = pack4_fp8(xv[j].x * rq, xv[j].y * rq, xv[j].z * rq, xv[j].w * rq);
            if (MODE & 8) { if (lane == 0) sel_e[tl * 4] = (int)rstd; continue; }
            float acc[32];
#pragma unroll
            for (int eb = 0; eb < 8; ++eb) {
#pragma unroll
                for (int e = 4 * eb; e < 4 * eb + 4; ++e) { float a = 0.f;
                    if (MODE & 1) { acc[e] = xv[e & 3].x * (float)e; continue; }
#pragma unroll
                    for (int j = 0; j < 4; ++j) { const f32x4 wv = *(const LAS f32x4*)(Wt + e * 1024 + 256 * j + 4 * lane); a += (xv[j].x * wv.x + xv[j].y * wv.y) + (xv[j].z * wv.z + xv[j].w * wv.w); }
                    acc[e] = a; }
                __builtin_amdgcn_sched_barrier(0);
            }
            const int e_me = lane >> 1;
            wave_reduce32(acc);
            float mine = acc[0];
#pragma unroll
            for (int i = 1; i < 8; ++i) mine = (((lane >> 1) & 7) == i) ? acc[i] : mine;
            float val = mine * rstd + br_me;
            int se[4]; float sv[4];
#pragma unroll
            for (int k = 0; k < 4; ++k) {
                if (MODE & 2) { se[k] = (lane + k) & 31; sv[k] = val; continue; }
                float bv = val; int bi = e_me;
#define RT_STEP(OV, OI) do { const float ov_ = (OV); const int oi_ = (OI); if (ov_ > bv || (ov_ == bv && oi_ < bi)) { bv = ov_; bi = oi_; } } while (0)
                RT_STEP(dpp_f<DPP_ROW_MIRROR>(bv), dpp_i<DPP_ROW_MIRROR>(bi));
                RT_STEP(dpp_f<DPP_ROW_HALF_MIRROR>(bv), dpp_i<DPP_ROW_HALF_MIRROR>(bi));
                RT_STEP(dpp_f<DPP_QUAD_REV>(bv), dpp_i<DPP_QUAD_REV>(bi));
                { const auto rv = __builtin_amdgcn_permlane16_swap(__float_as_uint(bv), __float_as_uint(bv), false, false); const auto ri = __builtin_amdgcn_permlane16_swap((unsigned)bi, (unsigned)bi, false, false);
                  float v0 = __uint_as_float(rv[0]), v1 = __uint_as_float(rv[1]); int i0 = (int)ri[0], i1 = (int)ri[1];
                  if (v1 > v0 || (v1 == v0 && i1 < i0)) { v0 = v1; i0 = i1; } bv = v0; bi = i0; }
                { const auto rv = __builtin_amdgcn_permlane32_swap(__float_as_uint(bv), __float_as_uint(bv), false, false); const auto ri = __builtin_amdgcn_permlane32_swap((unsigned)bi, (unsigned)bi, false, false);
                  float v0 = __uint_as_float(rv[0]), v1 = __uint_as_float(rv[1]); int i0 = (int)ri[0], i1 = (int)ri[1];
                  if (v1 > v0 || (v1 == v0 && i1 < i0)) { v0 = v1; i0 = i1; } bv = v0; bi = i0; }
#undef RT_STEP
                se[k] = bi; sv[k] = bv; if (e_me == bi) val = -INFINITY;
            }
            const float e1 = __expf(sv[1] - sv[0]), e2 = __expf(sv[2] - sv[0]), e3 = __expf(sv[3] - sv[0]); const float inv = 1.0f / (1.0f + e1 + e2 + e3);
            if (lane == 0) { sel_e[tl * 4 + 0] = se[0]; sel_e[tl * 4 + 1] = se[1]; sel_e[tl * 4 + 2] = se[2]; sel_e[tl * 4 + 3] = se[3];
                sel_g[tl * 4 + 0] = inv; sel_g[tl * 4 + 1] = e1 * inv; sel_g[tl * 4 + 2] = e2 * inv; sel_g[tl * 4 + 3] = e3 * inv; }
        }
        __syncthreads();
        const int a = F.tid, ea = sel_e[a];
        rank[a] = __hip_atomic_fetch_add(hist + ea, 1, __ATOMIC_RELAXED, __HIP_MEMORY_SCOPE_WORKGROUP);
        __syncthreads();
        if (F.tid < 32 && commit) base[F.tid] = (int)__hip_atomic_fetch_add((unsigned*)(F.ctl + CW_CNT + 64 * F.tid), (unsigned)hist[F.tid], RLX_AGENT);
        __syncthreads();
        if (commit) { const int pos = base[ea] + rank[a], t = blk * 128 + (a >> 2);
          F.rtok[(size_t)ea * CAP + pos] = t; F.rgate[(size_t)ea * CAP + pos] = sel_g[a]; F.tslot[(size_t)t * 4 + (a & 3)] = ((unsigned)ea << 16) | (unsigned)pos; }
        __syncthreads();
    }
}

__device__ __forceinline__ void moe_setup(Frame& F) {
    LAS int* tpre = (LAS int*)(F.aux + A_TPRE); LAS int* cnt = (LAS int*)(F.aux + A_CNT);
    if (F.tid < 32) cnt[F.tid] = (int)__hip_atomic_load((unsigned*)(F.ctl + CW_CNT + 64 * F.tid), RLX_AGENT);
    __syncthreads();
    if (F.tid == 0) { int s = 0; for (int e = 0; e < NE; ++e) { tpre[e] = s; s += (cnt[e] + 255) >> 8; } tpre[NE] = s; }
    __syncthreads();
}

__device__ __forceinline__ void combine_phase(Frame& F, float* dstbase) {
    const LAS int* tpre = (const LAS int*)(F.aux + A_TPRE);
    const int gw = F.vcu * NWAVES + F.wave, NGW = F.G * NWAVES, lane = F.lane;
    for (int t = gw; t < NTOK; t += 2 * NGW) {
        const int t2 = (t + NGW < NTOK) ? t + NGW : t;
        const u32x4 sa = *(const u32x4*)(F.tslot + (size_t)t * 4), sb = *(const u32x4*)(F.tslot + (size_t)t2 * 4);
        f32x4* orow = (f32x4*)(F.out + (size_t)t * DM) + lane; f32x4* orow2 = (f32x4*)(F.out + (size_t)t2 * DM) + lane;
        f32x4 v[4], w[4];
#pragma unroll
        for (int j = 0; j < 4; ++j) { v[j] = orow[64 * j]; w[j] = orow2[64 * j]; }
        u32x2 ya[4][4], yb[4][4];
#pragma unroll
        for (int k = 0; k < 4; ++k) {
            const unsigned s1 = sa[k], s2 = sb[k];
            const u32x2* y1 = (const u32x2*)(F.Y + ((size_t)tpre[s1 >> 16] * 256 + (s1 & 0xffffu)) * DM) + lane;
            const u32x2* y2 = (const u32x2*)(F.Y + ((size_t)tpre[s2 >> 16] * 256 + (s2 & 0xffffu)) * DM) + lane;
#pragma unroll
            for (int j = 0; j < 4; ++j) { ya[k][j] = y1[64 * j]; yb[k][j] = y2[64 * j]; }
        }
#pragma unroll
        for (int k = 0; k < 4; ++k)
#pragma unroll
            for (int j = 0; j < 4; ++j) {
                v[j].x += __uint_as_float(ya[k][j].x << 16); v[j].y += __uint_as_float(ya[k][j].x & 0xffff0000u); v[j].z += __uint_as_float(ya[k][j].y << 16); v[j].w += __uint_as_float(ya[k][j].y & 0xffff0000u);
                w[j].x += __uint_as_float(yb[k][j].x << 16); w[j].y += __uint_as_float(yb[k][j].x & 0xffff0000u); w[j].z += __uint_as_float(yb[k][j].y << 16); w[j].w += __uint_as_float(yb[k][j].y & 0xffff0000u); }
#pragma unroll
        for (int j = 0; j < 4; ++j) ((f32x4*)(dstbase + (size_t)t * DM) + lane)[64 * j] = v[j];
        if (t2 != t) {
#pragma unroll
            for (int j = 0; j < 4; ++j) ((f32x4*)(dstbase + (size_t)t2 * DM) + lane)[64 * j] = w[j]; }
    }
}

struct Args { const float* in[19]; float* out; unsigned char* ws; int ph_lo, ph_hi; };
template <int PLO, int PHI> __global__ void __launch_bounds__(NWAVES * 64, 2) hymba_fwd(Args args) {
    extern __shared__ __attribute__((aligned(16))) unsigned char lds[];
    Frame F;
    F.lds = (LAS unsigned char*)lds; F.aux = F.lds + AUX_OFF;
    F.tid = threadIdx.x; F.lane = F.tid & 63; F.wave = __builtin_amdgcn_readfirstlane(F.tid >> 6);
    F.G = gridDim.x; { const int bx = blockIdx.x; F.vcu = (F.G % 8 == 0) ? (bx % 8) * (F.G / 8) + bx / 8 : bx; }
    unsigned char* ws = args.ws;
    F.ctl = (gu32*)(ws + WS_CTL);
    F.x = args.in[0]; F.meta = args.in[1]; F.g1 = args.in[2]; F.w_in = args.in[3]; F.qg = args.in[4]; F.kg = args.in[5]; F.conv_w = args.in[6]; F.conv_b = args.in[7];
    F.ln_g = args.in[8]; F.ln_b = args.in[9]; F.og = args.in[10]; F.w_out = args.in[11]; F.g2 = args.in[12]; F.w_r = args.in[13]; F.b_r = args.in[14];
    F.w_up = args.in[15]; F.b_up = args.in[16]; F.w_dn = args.in[17]; F.b_dn = args.in[18]; F.out = args.out;
    F.WinT = (bf16*)(ws + WS_WIN); F.WoT = (bf16*)(ws + WS_WO); F.WdT = ws + WS_WD; F.WupT = ws + WS_WUP; F.NM = (bf16*)(ws + WS_NM);
    F.Q = (bf16*)(ws + WS_Q); F.Kh = (bf16*)(ws + WS_K); F.VT = (bf16*)(ws + WS_VT); F.HCV = (bf16*)(ws + WS_HCV); F.HN = ws + WS_HN; F.ACT = ws + WS_ACT; F.Y = (bf16*)(ws + WS_Y);
    F.rtok = (int*)(ws + WS_RTOK); F.rgate = (float*)(ws + WS_RGATE); F.tslot = (unsigned*)(ws + WS_TSLOT);
    for (int u = F.tid; u < 512 / 4; u += NWAVES * 64) ((LAS unsigned*)(F.lds + LDSCTL_OFF))[u] = 0u;
    __syncthreads();
    XcdBarrier bar; bar.bar = (unsigned*)(F.ctl + CW_BAR); bar.x = 0; bar.st = nullptr;
    if (PHI - PLO > 1) bar = xcd_barrier_post((unsigned*)(F.ctl + CW_BAR), (volatile LAS unsigned*)(F.lds + MISC_OFF) + 8);
    constexpr int lo = PLO, hi = PHI;
#ifndef PH_MASK
#define PH_MASK 0xff
#endif
#define IN(k) (((PH_MASK >> (k)) & 1) && lo <= (k) && (k) < hi)
#define SEAM(k) do { if (IN(k) && IN((k) + 1)) xcd_barrier(bar); } while (0)
    bool moe_ready = false;
#define FRESH() do { int t_ = threadIdx.x; asm volatile("" : "+v"(t_)); F.tid = t_; F.lane = t_ & 63; F.wave = __builtin_amdgcn_readfirstlane(t_ >> 6); } while (0)

    if (IN(0)) { FRESH(); p0_prologue<7>(F); if (NREP(0) > 1) { __syncthreads(); FRESH(); p0_prologue<(NREP(0) == 2 ? 7 : NREP(0) == 3 ? 2 : NREP(0) == 4 ? 4 : 1)>(F); } SEAM(0); }
    if (IN(1)) { FRESH();
        pg8::StaticSched S; S.init(NTOK, INC, DM, F.WinT, F.G, (int)blockIdx.x);
        pg8::EpiIn E{F.Q, F.Kh, F.VT, F.HCV, F.qg, F.kg};
        pg8::gemm_phase(F.lds, (const char*)F.NM, DM * 2, S, E, F.tid); if (NREP(1) > 1) { FRESH(); pg8::gemm_phase(F.lds, (const char*)F.NM, DM * 2, S, E, F.tid); }
        SEAM(1);
    }
    if (IN(2)) { FRESH(); conv_phase(F); if (NREP(2) > 1) { __syncthreads(); FRESH(); conv_phase(F); } __syncthreads(); attn_phase(F); if (NREP(7) > 1) { __syncthreads(); FRESH(); attn_phase(F); } SEAM(2); }
    if (IN(3)) { FRESH();
        pg8::StaticSched S; S.init(NTOK, DM, DM, F.WoT, F.G, (int)blockIdx.x);
        pg8::EpiRes E{F.x, F.out};
        pg8::gemm_phase(F.lds, (const char*)F.NM, DM * 2, S, E, F.tid); if (NREP(3) > 1) { FRESH(); pg8::gemm_phase(F.lds, (const char*)F.NM, DM * 2, S, E, F.tid); }
        SEAM(3);
    }
    if (IN(4)) { FRESH(); if (NREP(4) > 1) { router_phase<(NREP(4) > 1 ? (int)NREP(4) - 2 : 0)>(F, false); __syncthreads(); FRESH(); } router_phase<0>(F, true); SEAM(4); }
    if (IN(5)) { FRESH();
        if (!moe_ready) { moe_setup(F); moe_ready = true; }
        const LAS int* tpre = (const LAS int*)(F.aux + A_TPRE); const LAS int* cnt = (const LAS int*)(F.aux + A_CNT);
        LAS unsigned* idx = (LAS unsigned*)(F.aux + A_IDX);
        pg8::MoeSched<true> S; S.G = F.G; S.v = F.vcu; S.NT = 8; S.ntot = tpre[NE]; S.K2 = 1024u; S.Bt = (const char*)F.WupT; S.bstride = (size_t)2048 * 1024; S.tpre = tpre; S.idx = idx;
        { unsigned tkv[MAXU];
#pragma unroll
          for (int i = 0; i < MAXU; ++i) { pg8::Unit u; const bool ok = S.next(i, u); const int lr = u.rt * 256 + (F.tid & 255);
              tkv[i] = (ok && F.tid < 256 && lr < cnt[u.e]) ? (unsigned)F.rtok[(size_t)u.e * CAP + lr] : 0u; }
#pragma unroll
          for (int i = 0; i < MAXU; ++i) if (F.tid < 256) idx[i * 256 + F.tid] = tkv[i] * 1024u; }
        __syncthreads();
        pg8::EpiUp E{F.ACT, F.b_up};
        pg8::gemm_phase(F.lds, (const char*)F.HN, DM, S, E, F.tid); if (NREP(5) > 1) { FRESH(); pg8::gemm_phase(F.lds, (const char*)F.HN, DM, S, E, F.tid); }
        SEAM(5);
    }
    if (IN(6)) { FRESH();
        if (!moe_ready) { moe_setup(F); moe_ready = true; }
        const LAS int* tpre = (const LAS int*)(F.aux + A_TPRE);
        pg8::MoeSched<false> S; S.G = F.G; S.v = F.vcu; S.NT = 4; S.ntot = tpre[NE]; S.K2 = 1024u; S.Bt = (const char*)F.WdT; S.bstride = (size_t)1024 * 1024; S.tpre = tpre; S.idx = nullptr;
        pg8::EpiDown E{F.Y, F.b_dn, F.rgate};
        pg8::gemm_phase(F.lds, (const char*)F.ACT, DE, S, E, F.tid); if (NREP(6) > 1) { FRESH(); pg8::gemm_phase(F.lds, (const char*)F.ACT, DE, S, E, F.tid); }
        SEAM(6);
    }
    if (IN(7)) { FRESH();
        if (!moe_ready) { moe_setup(F); moe_ready = true; }
        if (PROBE_P7) { combine_phase(F, (float*)(ws + WS_ACT)); __syncthreads(); FRESH(); }
        combine_phase(F, F.out);
    }
#undef IN
#undef SEAM
}

template <int PLO, int PHI> static bool launch_range(int& grid, const Args& a, hipStream_t stream) {
    static bool ready = false;
    if (!ready) {
        int dev = 0, cus = 0, per_cu = 0;
        if (hipGetDevice(&dev) != hipSuccess || hipDeviceGetAttribute(&cus, hipDeviceAttributeMultiprocessorCount, dev) != hipSuccess) return false;
        if (hipFuncSetAttribute((const void*)hymba_fwd<PLO, PHI>, hipFuncAttributeMaxDynamicSharedMemorySize, LDS_BYTES) != hipSuccess) { fprintf(stderr, "kernel_launch: hipFuncSetAttribute failed\n"); return false; }
        if (hipOccupancyMaxActiveBlocksPerMultiprocessor(&per_cu, (const void*)hymba_fwd<PLO, PHI>, NWAVES * 64, LDS_BYTES) != hipSuccess || per_cu < 1) fprintf(stderr, "kernel_launch: occupancy query says %d\n", per_cu);
        (void)hipGetLastError();
        grid = cus;
        ready = true;
    }
    hipLaunchKernelGGL((hymba_fwd<PLO, PHI>), dim3(grid), dim3(NWAVES * 64), LDS_BYTES, stream, a);
    return true;
}
extern "C" void kernel_launch(void* const* d_in, const int* in_sizes, int n_in, void* d_out, int out_size, void* d_ws, size_t ws_size, hipStream_t stream) {
    static int grid = 0;
    if (grid < 0) return;
    if (n_in != 19 || in_sizes[0] != NTOK * DM || out_size != NTOK * DM || ws_size < WS_END) { fprintf(stderr, "kernel_launch: unexpected shapes (n_in %d, ws %zu); nothing launched\n", n_in, ws_size); grid = -1; return; }
    if (hipMemsetAsync((char*)d_ws + WS_CTL, 0, CTL_ZERO_BYTES, stream) != hipSuccess) return;
    Args a{};
    for (int i = 0; i < 19; ++i) a.in[i] = (const float*)d_in[i];
    a.out = (float*)d_out; a.ws = (unsigned char*)d_ws; a.ph_lo = 0; a.ph_hi = 8;
#if MK_N_LAUNCHES == 1
    if (!launch_range<0, 8>(grid, a, stream)) grid = -1;
#else
    bool ok = launch_range<0, 1>(grid, a, stream) && launch_range<1, 2>(grid, a, stream) && launch_range<2, 3>(grid, a, stream) && launch_range<3, 4>(grid, a, stream)
           && launch_range<4, 5>(grid, a, stream) && launch_range<5, 6>(grid, a, stream) && launch_range<6, 7>(grid, a, stream) && launch_range<7, 8>(grid, a, stream);
    if (!ok) grid = -1;
#endif
}
```

```cpp
#include <hip/hip_runtime.h>
#include <cstdio>
#include <cstdint>

#ifndef MK_N_LAUNCHES
#define MK_N_LAUNCHES 1
#endif
#ifndef PROBE_REP
#define PROBE_REP 0
#endif
#ifndef PROBE_P7
#define PROBE_P7 0
#endif
#define NREP(k) ((((unsigned)PROBE_REP >> (4 * (k))) & 15u) + 1u)
#ifndef ATTN_EARLY
#define ATTN_EARLY 1
#endif

#define LAS __attribute__((address_space(3)))
#define GAS __attribute__((address_space(1)))
typedef unsigned short bf16;
typedef short bf16x8 __attribute__((ext_vector_type(8)));
typedef float f32x2 __attribute__((ext_vector_type(2)));
typedef float f32x4 __attribute__((ext_vector_type(4)));
typedef float f32x16 __attribute__((ext_vector_type(16)));
typedef unsigned u32x2 __attribute__((ext_vector_type(2)));
typedef unsigned u32x4 __attribute__((ext_vector_type(4)));
typedef GAS unsigned gu32;
typedef int i32x8 __attribute__((ext_vector_type(8)));

constexpr int NB = 8, SEQ = 4096, DM = 1024, NTOK = NB * SEQ;
constexpr int NMETA = 16, LPAD = 16, LP = LPAD + NMETA + SEQ;
constexpr int NH = 8, HD = 64, SBW = 512, CW = 512, CKW = 31, INC = 2560;
constexpr int NE = 32, TOPK = 4, DE = 1024, CAP = NTOK;
constexpr int MAXROWS = NTOK * TOPK + NE * 256;
constexpr float EPS = 1e-6f;
constexpr float LOG2E = 1.4426950408889634f;
constexpr float QSCALE = 0.125f * LOG2E;
constexpr float SW_LIMIT = 7.0f, SW_ALPHA = 1.702f;
constexpr float ATTN_CUT = 1e-30f;
constexpr float SC_W = 128.0f, SC_HN = 8.0f, SC_ACT = 4.0f, SC_Y = 32.0f, F8_MAX = 448.0f;

constexpr size_t MiB = 1u << 20;
constexpr size_t WS_CTL = 0, CTL_ZERO_BYTES = 1 * MiB;
constexpr size_t WS_WIN = 1 * MiB, WS_WO = 6 * MiB, WS_WD = 8 * MiB, WS_WUP = 72 * MiB;
constexpr size_t WS_NM = 200 * MiB;
constexpr size_t WS_Q = 264 * MiB, WS_K = 296 * MiB, WS_VT = 329 * MiB, WS_HCV = 362 * MiB;
constexpr size_t WS_ACT = 395 * MiB;
constexpr size_t WS_RTOK = 667 * MiB, WS_RGATE = 671 * MiB, WS_TSLOT = 675 * MiB, WS_RFRAG = 676 * MiB, WS_END = 677 * MiB;
constexpr size_t WS_HN = WS_Q;
constexpr size_t WS_Y = WS_WUP;
static_assert(WS_Y + (size_t)MAXROWS * 2048 <= WS_HCV && WS_ACT + (size_t)MAXROWS * 2048 <= WS_RTOK, "ws map");
constexpr int CW_TMO = 0, CW_BAR = 4096, CW_CNT = 8192;

constexpr int RING_BYTES = 131072;
constexpr int LDSCTL_OFF = RING_BYTES, MISC_OFF = LDSCTL_OFF + 320, AUX_OFF = LDSCTL_OFF + 512;
constexpr int A_TPRE = 0, A_CNT = 256, A_HIST = 384, A_BASE = 512, A_RED = 640, A_TOT = 1664, A_SELE = 1792, A_SELG = 3840, A_RANK = 5888, A_IDX = 8192;
constexpr int MAXU = 17;
constexpr int LDS_BYTES = AUX_OFF + A_IDX + MAXU * 1024;
static_assert(LDS_BYTES <= 163840, "LDS");
constexpr int NWAVES = 8;

#define LDS_WAIT() asm volatile("s_waitcnt lgkmcnt(0)" ::: "memory")
#define VM_WAIT() asm volatile("s_waitcnt vmcnt(0)" ::: "memory")
#define RLX_AGENT __ATOMIC_RELAXED, __HIP_MEMORY_SCOPE_AGENT

__device__ __forceinline__ unsigned cvt_pk_bf16(float lo, float hi) { unsigned r; asm volatile("v_cvt_pk_bf16_f32 %0, %1, %2" : "=v"(r) : "v"(lo), "v"(hi)); return r; }
__device__ __forceinline__ float bf2f(bf16 b) { return __uint_as_float(((unsigned)b) << 16); }
__device__ __forceinline__ bf16 f2bf(float f) { return (bf16)(cvt_pk_bf16(f, 0.f) & 0xffffu); }
__device__ __forceinline__ unsigned pack4_fp8(float a, float b, float c, float d) {
    a = __builtin_amdgcn_fmed3f(a, -F8_MAX, F8_MAX); b = __builtin_amdgcn_fmed3f(b, -F8_MAX, F8_MAX); c = __builtin_amdgcn_fmed3f(c, -F8_MAX, F8_MAX); d = __builtin_amdgcn_fmed3f(d, -F8_MAX, F8_MAX);
    int p = __builtin_amdgcn_cvt_pk_fp8_f32(a, b, 0, false); p = __builtin_amdgcn_cvt_pk_fp8_f32(c, d, p, true); return (unsigned)p;
}
__device__ __forceinline__ float fast_rcp(float x) { return __builtin_amdgcn_rcpf(x); }
__device__ __forceinline__ float fast_exp2(float x) { return __builtin_amdgcn_exp2f(x); }
__device__ __forceinline__ float sigmoidf_(float x) { return fast_rcp(1.0f + fast_exp2(-x * LOG2E)); }
template <int CTRL> __device__ __forceinline__ float dpp_f(float v) { return __builtin_bit_cast(float, __builtin_amdgcn_update_dpp(0, __builtin_bit_cast(int, v), CTRL, 0xf, 0xf, true)); }
template <int CTRL> __device__ __forceinline__ int dpp_i(int v) { return __builtin_amdgcn_update_dpp(0, v, CTRL, 0xf, 0xf, true); }
#define DPP_ROW_MIRROR 0x140
#define DPP_ROW_HALF_MIRROR 0x141
#define DPP_QUAD_REV 0x1B
#define DPP_QUAD_SWAP 0xB1
__device__ __forceinline__ float row_allsum(float v) {
    v += dpp_f<DPP_ROW_MIRROR>(v); v += dpp_f<DPP_ROW_HALF_MIRROR>(v); v += dpp_f<DPP_QUAD_REV>(v); v += dpp_f<DPP_QUAD_SWAP>(v); return v;
}
__device__ __forceinline__ float swap16_sum(float a, float b) {
    const auto r = __builtin_amdgcn_permlane16_swap(__float_as_uint(a), __float_as_uint(b), false, false); return __uint_as_float(r[0]) + __uint_as_float(r[1]);
}
__device__ __forceinline__ float swap32_sum(float a, float b) {
    const auto r = __builtin_amdgcn_permlane32_swap(__float_as_uint(a), __float_as_uint(b), false, false); return __uint_as_float(r[0]) + __uint_as_float(r[1]);
}
__device__ __forceinline__ float wave_sum(float v) { v = row_allsum(v); v = swap16_sum(v, v); return swap32_sum(v, v); }
__device__ __forceinline__ void wave_reduce32(float (&v)[32]) {
#pragma unroll
    for (int i = 0; i < 16; ++i) v[i] = swap32_sum(v[i], v[i + 16]);
#pragma unroll
    for (int i = 0; i < 8; ++i) v[i] = swap16_sum(v[i], v[i + 8]);
#pragma unroll
    for (int i = 0; i < 8; ++i) v[i] = row_allsum(v[i]);
}
#define XB_TMO      128
#define XB_XCNT(j)  (256  + 64 * (j))
#define XB_XSUB(j)  (1280 + 64 * (j))
#define XB_XGEN(j)  (2304 + 64 * (j))
#define XB_TOP      3328
#define XB_TOPGEN   3392
#define XCD_BAR_WORDS 3456
#define XB_SPIN_CAP (1u << 18)
__device__ __forceinline__ unsigned xb_ld(unsigned* p)              { return __hip_atomic_load(p, __ATOMIC_RELAXED, __HIP_MEMORY_SCOPE_AGENT); }
__device__ __forceinline__ unsigned xb_add(unsigned* p, unsigned v) { return __hip_atomic_fetch_add(p, v, __ATOMIC_RELAXED, __HIP_MEMORY_SCOPE_AGENT); }
__device__ __forceinline__ unsigned xb_xcc_id() { return (unsigned)__builtin_amdgcn_s_getreg((3 << 11) | 20) & 0xFu; }
#define XB_SPIN(cond, bar) do { unsigned _sp = 0; while (cond) { __builtin_amdgcn_s_sleep(1); \
    if ((++_sp & 255u) == 0u) { if (xb_ld(&(bar)[XB_TMO])) break; if (_sp > XB_SPIN_CAP) { atomicAdd(&(bar)[XB_TMO], 1u); break; } } } } while (0)
struct XcdBarrier { unsigned* bar; unsigned x; volatile LAS unsigned* st; };
__device__ __forceinline__ XcdBarrier xcd_barrier_post(unsigned* bar, volatile LAS unsigned* st) {
    XcdBarrier b; b.bar = bar; b.x = xb_xcc_id(); b.st = st;
    if (threadIdx.x == 0) (void)xb_add(&bar[XB_XCNT(b.x)], 1u);
    return b;
}
__device__ __forceinline__ void xcd_barrier_complete(unsigned* bar, unsigned x, unsigned& nloc, unsigned& nx) {
    const unsigned G = gridDim.x * gridDim.y * gridDim.z;
    unsigned sum, cnt, mine, sp = 0u;
    for (;;) {
        sum = 0u; cnt = 0u; mine = 0u;
#pragma unroll
        for (unsigned j = 0; j < 16; ++j) { const unsigned c = xb_ld(&bar[XB_XCNT(j)]); sum += c; cnt += (c > 0u) ? 1u : 0u; mine = (j == x) ? c : mine; }
        if (sum == G) break;
        __builtin_amdgcn_s_sleep(1);
        if ((++sp & 255u) == 0u) { if (xb_ld(&bar[XB_TMO])) break; if (sp > XB_SPIN_CAP) { atomicAdd(&bar[XB_TMO], 1u); break; } }
    }
    nloc = mine > 0u ? mine : 1u; nx = cnt > 0u ? cnt : 1u;
}
__device__ __forceinline__ void xcd_barrier(const XcdBarrier& b) {
    asm volatile("s_waitcnt vmcnt(0)" ::: "memory");
    __syncthreads();
    if (threadIdx.x == 0) {
        unsigned* bar = b.bar;
        __builtin_amdgcn_s_waitcnt(0);
        unsigned nloc = b.st[0], nx = b.st[1];
        if (nloc == 0u) { xcd_barrier_complete(bar, b.x, nloc, nx); b.st[0] = nloc; b.st[1] = nx; }
        const unsigned old = xb_add(&bar[XB_XSUB(b.x)], 1u);
        const unsigned gen = old / nloc;
        if (old + 1u == (gen + 1u) * nloc) {
            __builtin_amdgcn_fence(__ATOMIC_RELEASE, "agent");
            asm volatile("s_waitcnt vmcnt(0)" ::: "memory");
            const unsigned og = xb_add(&bar[XB_TOP], 1u);
            const unsigned tg = og / nx;
            if (og + 1u == (tg + 1u) * nx) xb_add(&bar[XB_TOPGEN], 1u);
            else XB_SPIN(xb_ld(&bar[XB_TOPGEN]) == tg, bar);
            __builtin_amdgcn_fence(__ATOMIC_ACQUIRE, "agent");
            xb_add(&bar[XB_XGEN(b.x)], 1u);
            asm volatile("s_waitcnt vmcnt(0)" ::: "memory");
        } else {
            XB_SPIN(xb_ld(&bar[XB_XGEN(b.x)]) == gen, bar);
            __builtin_amdgcn_fence(__ATOMIC_ACQUIRE, "agent");
            asm volatile("s_waitcnt vmcnt(0)" ::: "memory");
        }
    }
    __syncthreads();
}

namespace pg8 {
constexpr int BM = 256, BK = 64, HALF = 128, HTB = HALF * BK * 2, STAGE_BYTES = 8 * HTB, NXCD = 8, WGM = 8;
__device__ __forceinline__ int lds_byte(int r, int c) { const int st = (r >> 4) * 2 + (c >> 5), rr = r & 15, cc = c & 31, ob = rr * 64 + cc * 2; return st * 1024 + (ob ^ (((ob >> 9) & 1) << 5)); }
__device__ __forceinline__ void stage_rc(int b, int& R, int& C) { const int st = b / 1024, sb = b % 1024, swz = sb ^ (((sb >> 9) & 1) << 5); R = (st >> 1) * 16 + swz / 64; C = (st & 1) * 32 + (swz % 64) / 2; }
__device__ __forceinline__ int perm32(int rho) { const int n = rho >> 4, i = rho & 15; return 8 * (i >> 2) + 4 * n + (i & 3); }

struct Unit { int pm, pn, e, rt; };

struct StaticSched {
    int nM, nN, nwg, G, c; unsigned K2; const char* Bt;
    __device__ void init(int M, int N, int K, const void* Bt_, int G_, int c_) { nM = M / BM; nN = N / BM; nwg = nM * nN; G = G_; c = c_; K2 = (unsigned)K * 2u; Bt = (const char*)Bt_; }
    __device__ __forceinline__ bool next(int i, Unit& u) const {
        const long L = (long)i * G + c; if (L >= nwg) return false;
        int wgid = (int)L; { const int q = nwg / NXCD, r = nwg % NXCD, xcd = wgid % NXCD, off = wgid / NXCD; wgid = (xcd < r ? xcd * (q + 1) : r * (q + 1) + (xcd - r) * q) + off; }
        const int nig = WGM * nN, gid = wgid / nig, fm = gid * WGM, gsz = (nM - fm) < WGM ? (nM - fm) : WGM;
        u.pm = fm + ((wgid % nig) % gsz); u.pn = (wgid % nig) / gsz; u.e = 0; u.rt = 0; return true;
    }
    __device__ __forceinline__ unsigned aoff(int, const Unit& u, int row) const { return (unsigned)(u.pm * BM + row) * K2; }
    __device__ __forceinline__ const char* bbase() const { return Bt; }
    __device__ __forceinline__ unsigned boff(const Unit& u) const { return (unsigned)(u.pn * BM) * K2; }
};
template <bool GATHER> struct MoeSched {
    int G, v, NT, ntot; unsigned K2; const char* Bt; size_t bstride; const LAS int* tpre; const LAS unsigned* idx;
    __device__ __forceinline__ bool next(int i, Unit& u) const {
        const int U = i * G + v; if (U >= ntot * NT) return false;
        const int rtg = U / NT; u.pm = rtg; u.pn = U - rtg * NT;
        int lo = 0, hi = NE;
#pragma unroll
        for (int s = 0; s < 5; ++s) { const int mid = (lo + hi) >> 1; const int t = __builtin_amdgcn_readfirstlane(tpre[mid]); if (rtg >= t) lo = mid; else hi = mid; }
        u.e = lo; u.rt = rtg - __builtin_amdgcn_readfirstlane(tpre[lo]); return true;
    }
    __device__ __forceinline__ unsigned aoff(int i, const Unit& u, int row) const { if (GATHER) return idx[i * 256 + row]; return (unsigned)(u.pm * BM + row) * K2; }
    __device__ __forceinline__ const char* bbase() const { return Bt; }
    __device__ __forceinline__ unsigned boff(const Unit& u) const { return (unsigned)u.e * (unsigned)bstride + (unsigned)(u.pn * BM) * K2; }
};

template <class Epi, class Sched>
__device__ __forceinline__ void gemm_phase(LAS unsigned char* lds, const char* Abase, const int KB  , const Sched& S, const Epi& E, const int tid) {
    const int wid = __builtin_amdgcn_readfirstlane(tid >> 6), lane = tid & 63, wr = wid >> 2, wc = wid & 3, fr = lane & 15, fq = lane >> 4;
    const int nt = KB / 128;
    int Rr[2]; unsigned colA[2], voffB[2];
#pragma unroll
    for (int i = 0; i < 2; ++i) { int R, C; stage_rc(tid * 16 + i * 8192, R, C); const int Rb = Epi::PERM ? ((R & ~31) + perm32(R & 31)) : R;
        Rr[i] = R; colA[i] = (unsigned)C * 2u; voffB[i] = (unsigned)(Rb * KB + C * 2); }
    const unsigned kstep = (unsigned)(BK * 2);
    const unsigned hstep = (unsigned)HALF * (unsigned)KB;
    const unsigned ldsw = (unsigned)wid * 1024u;
    const int aoff = lds_byte(wr * 64 + fr, fq * 8), boff = lds_byte(wc * 32 + fr, fq * 8);
    const __amdgpu_buffer_rsrc_t rA = __builtin_amdgcn_make_buffer_rsrc((void*)Abase, 0, 0xffffffff, 0x00020000);
    const __amdgpu_buffer_rsrc_t rB = __builtin_amdgcn_make_buffer_rsrc((void*)S.bbase(), 0, 0xffffffff, 0x00020000);
#define PG8_SA(b, h) (((b) * 2 + (h)) * HTB)
#define PG8_SB(b, h) ((4 + (b) * 2 + (h)) * HTB)
#define PG8_STAGEB(bufoff, soff) do { _Pragma("unroll") for (int _i = 0; _i < 2; ++_i) \
        __builtin_amdgcn_raw_ptr_buffer_load_lds(rB, (LAS unsigned*)(lds + (bufoff) + ldsw + _i * 8192), 16, voffB[_i], (soff), 0, 0); } while (0)
#define PG8_STAGEA(bufoff, offs, soff) do { _Pragma("unroll") for (int _i = 0; _i < 2; ++_i) \
        __builtin_amdgcn_raw_ptr_buffer_load_lds(rA, (LAS unsigned*)(lds + (bufoff) + ldsw + _i * 8192), 16, (offs)[_i], (soff), 0, 0); } while (0)
#define PG8_LDA(dst, b, h) do { _Pragma("unroll") for (int m = 0; m < 4; ++m) _Pragma("unroll") for (int k = 0; k < 2; ++k) dst[m][k] = *(const LAS bf16x8*)(lds + PG8_SA(b, h) + aoff + m * 2048 + k * 1024); } while (0)
#define PG8_LDB(dst, b, h) do { _Pragma("unroll") for (int n = 0; n < 2; ++n) _Pragma("unroll") for (int k = 0; k < 2; ++k) dst[n][k] = *(const LAS bf16x8*)(lds + PG8_SB(b, h) + boff + n * 2048 + k * 1024); } while (0)
#define PG8_CAT(x) __builtin_shufflevector(__builtin_bit_cast(u32x4, (x)[0]), __builtin_bit_cast(u32x4, (x)[1]), 0, 1, 2, 3, 4, 5, 6, 7)
#define PG8_MMA(ai, bj, At, Bt) do { __builtin_amdgcn_s_setprio(1); \
        if constexpr (Epi::FP8) { _Pragma("unroll") for (int m = 0; m < 4; ++m) _Pragma("unroll") for (int n = 0; n < 2; ++n) \
            { const i32x8 b8_ = __builtin_bit_cast(i32x8, PG8_CAT(Bt[n])), a8_ = __builtin_bit_cast(i32x8, PG8_CAT(At[m])); \
              asm volatile("v_mfma_f32_16x16x128_f8f6f4 %0, %1, %2, %0" : "+v"(acc[ai][bj][m][n]) : "v"(b8_), "v"(a8_)); } } \
        else { _Pragma("unroll") for (int m = 0; m < 4; ++m) _Pragma("unroll") for (int n = 0; n < 2; ++n) _Pragma("unroll") for (int k = 0; k < 2; ++k) \
            acc[ai][bj][m][n] = __builtin_amdgcn_mfma_f32_16x16x32_bf16(Bt[n][k], At[m][k], acc[ai][bj][m][n], 0, 0, 0); } \
        __builtin_amdgcn_s_setprio(0); } while (0)
#define PG8_WAIT_V(n) asm volatile("s_waitcnt vmcnt(" #n ")" ::: "memory")
#define PG8_WAIT_L(n) asm volatile("s_waitcnt lgkmcnt(" #n ")" ::: "memory")
#define PG8_BAR __builtin_amdgcn_s_barrier()
#define PG8_SCHED __builtin_amdgcn_sched_barrier(0)
#define PG8_KPAIR(K1, A20, A21, KA2, B2) do { \
            PG8_LDB(B0, 0, 0); PG8_LDB(B1, 0, 1); PG8_SCHED; PG8_LDA(At, 0, 0); PG8_STAGEA(PG8_SA(1, 1), ca1, (K1)); \
            PG8_WAIT_V(8); PG8_WAIT_L(0); PG8_BAR; PG8_MMA(0, 0, At, B0); PG8_MMA(0, 1, At, B1); PG8_BAR; PG8_SCHED; \
            PG8_LDA(At, 0, 1); PG8_STAGEB(PG8_SB(0, 0), (B2)); PG8_STAGEB(PG8_SB(0, 1), (B2) + hstep); PG8_STAGEA(PG8_SA(0, 0), A20, (KA2)); \
            PG8_WAIT_V(8); PG8_WAIT_L(0); PG8_BAR; PG8_MMA(1, 0, At, B0); PG8_MMA(1, 1, At, B1); PG8_BAR; PG8_SCHED; \
            PG8_LDB(B0, 1, 0); PG8_LDB(B1, 1, 1); PG8_SCHED; PG8_LDA(At, 1, 0); PG8_STAGEA(PG8_SA(0, 1), A21, (KA2)); \
            PG8_WAIT_V(8); PG8_WAIT_L(0); PG8_BAR; PG8_MMA(0, 0, At, B0); PG8_MMA(0, 1, At, B1); PG8_BAR; PG8_SCHED; \
            PG8_LDA(At, 1, 1); PG8_STAGEB(PG8_SB(1, 0), (B2) + kstep); PG8_STAGEB(PG8_SB(1, 1), (B2) + kstep + hstep); PG8_STAGEA(PG8_SA(1, 0), A20, (KA2) + kstep); \
            PG8_WAIT_V(8); PG8_WAIT_L(0); PG8_BAR; PG8_MMA(1, 0, At, B0); PG8_MMA(1, 1, At, B1); PG8_BAR; PG8_SCHED; } while (0)
    Unit cur, nxt; int ui = 0;
    if (!S.next(0, cur)) return;
    f32x4 acc[2][2][4][2];
#pragma unroll
    for (int a = 0; a < 2; ++a)
#pragma unroll
        for (int b = 0; b < 2; ++b)
#pragma unroll
            for (int m = 0; m < 4; ++m)
#pragma unroll
                for (int n = 0; n < 2; ++n) acc[a][b][m][n] = (f32x4){0.f, 0.f, 0.f, 0.f};
    bf16x8 At[4][2], B0[2][2], B1[2][2];
    unsigned ca0[2], ca1[2], na0[2], na1[2];
#pragma unroll
    for (int i = 0; i < 2; ++i) { ca0[i] = S.aoff(0, cur, Rr[i]) + colA[i]; ca1[i] = S.aoff(0, cur, HALF + Rr[i]) + colA[i]; }
    unsigned cB = S.boff(cur);
    PG8_STAGEB(PG8_SB(0, 0), cB); PG8_STAGEB(PG8_SB(0, 1), cB + hstep); PG8_STAGEA(PG8_SA(0, 0), ca0, 0u); PG8_STAGEA(PG8_SA(0, 1), ca1, 0u);
    if (wr == 1) PG8_BAR;
    PG8_WAIT_V(2); PG8_BAR;
    PG8_STAGEB(PG8_SB(1, 0), cB + kstep); PG8_STAGEA(PG8_SA(1, 0), ca0, kstep); PG8_STAGEB(PG8_SB(1, 1), cB + hstep + kstep);
    PG8_WAIT_V(6); PG8_BAR;
    for (;;) {
        const bool has_next = S.next(ui + 1, nxt);
        const unsigned nB = has_next ? S.boff(nxt) : cB;
#pragma unroll
        for (int i = 0; i < 2; ++i) { na0[i] = has_next ? S.aoff(ui + 1, nxt, Rr[i]) + colA[i] : ca0[i]; na1[i] = has_next ? S.aoff(ui + 1, nxt, HALF + Rr[i]) + colA[i] : ca1[i]; }
#pragma unroll 1
        for (int t = 0; t < nt - 2; t += 2) { const unsigned k1 = (unsigned)(t + 1) * kstep, k2 = (unsigned)(t + 2) * kstep; PG8_KPAIR(k1, ca0, ca1, k2, cB + k2); }
        { const unsigned k1 = (unsigned)(nt - 1) * kstep; PG8_KPAIR(k1, na0, na1, 0u, nB); }
        if (wr == 0) PG8_BAR;
        if constexpr (Epi::FP8) asm volatile("s_nop 15\n\ts_nop 7" ::: "memory");
        E(acc, cur, wr, wc, fr, fq);
        if (!has_next) break;
#pragma unroll
        for (int a = 0; a < 2; ++a)
#pragma unroll
            for (int b = 0; b < 2; ++b)
#pragma unroll
                for (int m = 0; m < 4; ++m)
#pragma unroll
                    for (int n = 0; n < 2; ++n) acc[a][b][m][n] = (f32x4){0.f, 0.f, 0.f, 0.f};
        cur = nxt; cB = nB; ++ui;
#pragma unroll
        for (int i = 0; i < 2; ++i) { ca0[i] = na0[i]; ca1[i] = na1[i]; }
        if (wr == 1) PG8_BAR;
    }
    PG8_WAIT_V(0);
    PG8_BAR;
#undef PG8_KPAIR
#undef PG8_CAT
#undef PG8_SA
#undef PG8_SB
#undef PG8_STAGEA
#undef PG8_STAGEB
#undef PG8_LDA
#undef PG8_LDB
#undef PG8_MMA
#undef PG8_WAIT_V
#undef PG8_WAIT_L
#undef PG8_BAR
#undef PG8_SCHED
}

struct EpiIn {
    static constexpr bool PERM = true, FP8 = false;
    bf16 *Q, *Kh, *VT, *HCV; const float *qg, *kg;
    __device__ __forceinline__ void operator()(const f32x4 (&acc)[2][2][4][2], const Unit& u, int wr, int wc, int fr, int fq) const {
        const int pn = u.pn;
        const int row0 = u.pm * BM + wr * 64 + fr;
        if (pn < 4) {
            const bool isq = pn < 2; const float* g = isq ? qg : kg; const float sc = isq ? QSCALE : 1.0f;
            const int head = 4 * (pn & 1) + wc;
            f32x4 gv[2][2];
#pragma unroll
            for (int bj = 0; bj < 2; ++bj)
#pragma unroll
                for (int n = 0; n < 2; ++n) gv[bj][n] = *(const f32x4*)(g + 32 * bj + 8 * fq + 4 * n) * sc;
#pragma unroll
            for (int ai = 0; ai < 2; ++ai)
#pragma unroll
                for (int m = 0; m < 4; ++m) {
                    float ss = 0.f;
#pragma unroll
                    for (int bj = 0; bj < 2; ++bj)
#pragma unroll
                        for (int n = 0; n < 2; ++n) { const f32x4 x = acc[ai][bj][m][n]; ss += (x[0] * x[0] + x[1] * x[1]) + (x[2] * x[2] + x[3] * x[3]); }
                    ss += __shfl_xor(ss, 16); ss += __shfl_xor(ss, 32);
                    const float rs = __builtin_amdgcn_rsqf(ss * (1.0f / 64.0f) + EPS);
                    const int row = row0 + ai * HALF + m * 16, b = row >> 12, t = row & 4095;
                    bf16* dst = isq ? Q + ((size_t)(b * NH + head) * SEQ + t) * HD : Kh + ((size_t)(b * NH + head) * LP + 32 + t) * HD;
#pragma unroll
                    for (int bj = 0; bj < 2; ++bj) { const f32x4 v0 = acc[ai][bj][m][0] * rs * gv[bj][0], v1 = acc[ai][bj][m][1] * rs * gv[bj][1];
                        u32x4 w; w.x = cvt_pk_bf16(v0[0], v0[1]); w.y = cvt_pk_bf16(v0[2], v0[3]); w.z = cvt_pk_bf16(v1[0], v1[1]); w.w = cvt_pk_bf16(v1[2], v1[3]);
                        *(u32x4*)(dst + 32 * bj + 8 * fq) = w; }
                }
        } else if (pn < 6) {
            const int head = 4 * (pn & 1) + wc;
#pragma unroll
            for (int ai = 0; ai < 2; ++ai)
#pragma unroll
                for (int m = 0; m < 4; ++m) {
                    const int row = row0 + ai * HALF + m * 16, b = row >> 12, t = row & 4095;
                    bf16* dst = VT + ((size_t)(b * NH + head) * HD) * LP + 32 + t;
#pragma unroll
                    for (int bj = 0; bj < 2; ++bj)
#pragma unroll
                        for (int n = 0; n < 2; ++n)
#pragma unroll
                            for (int e = 0; e < 4; ++e) dst[(size_t)(32 * bj + 8 * fq + 4 * n + e) * LP] = f2bf(acc[ai][bj][m][n][e]);
                }
        } else {
            const int ch0 = 128 * (pn - 6) + 32 * wc + 8 * fq;
#pragma unroll
            for (int ai = 0; ai < 2; ++ai)
#pragma unroll
                for (int m = 0; m < 4; ++m) {
                    const int row = row0 + ai * HALF + m * 16, b = row >> 12, t = row & 4095;
                    f32x4 h0, h1;
#pragma unroll
                    for (int e = 0; e < 4; ++e) { h0[e] = acc[ai][0][m][0][e] * sigmoidf_(acc[ai][1][m][0][e]); h1[e] = acc[ai][0][m][1][e] * sigmoidf_(acc[ai][1][m][1][e]); }
                    u32x4 w; w.x = cvt_pk_bf16(h0[0], h0[1]); w.y = cvt_pk_bf16(h0[2], h0[3]); w.z = cvt_pk_bf16(h1[0], h1[1]); w.w = cvt_pk_bf16(h1[2], h1[3]);
                    *(u32x4*)(HCV + ((size_t)b * LP + 32 + t) * CW + ch0) = w;
                }
        }
    }
};
struct EpiRes {
    static constexpr bool PERM = false, FP8 = false;
    const float* X; float* O;
    __device__ __forceinline__ void operator()(const f32x4 (&acc)[2][2][4][2], const Unit& u, int wr, int wc, int fr, int fq) const {
        const int row0 = u.pm * BM + wr * 64 + fr, col0 = u.pn * BM + wc * 32 + 4 * fq;
#pragma unroll
        for (int ai = 0; ai < 2; ++ai)
#pragma unroll
            for (int m = 0; m < 4; ++m) { const size_t off = (size_t)(row0 + ai * HALF + m * 16) * DM + col0;
#pragma unroll
                for (int bj = 0; bj < 2; ++bj)
#pragma unroll
                    for (int n = 0; n < 2; ++n) { const f32x4 xv = *(const f32x4*)(X + off + bj * HALF + n * 16); *(f32x4*)(O + off + bj * HALF + n * 16) = xv + acc[ai][bj][m][n]; } }
    }
};
struct EpiUp {
    static constexpr bool PERM = true, FP8 = true;
    unsigned char* ACT; const float* bup;
    __device__ __forceinline__ void operator()(const f32x4 (&acc)[2][2][4][2], const Unit& u, int wr, int wc, int fr, int fq) const {
        const int c0 = 128 * u.pn + 32 * wc + 8 * fq;
        const float* bb = bup + (size_t)u.e * 2048 + c0;
        const f32x4 bg0 = *(const f32x4*)(bb), bg1 = *(const f32x4*)(bb + 4), bl0 = *(const f32x4*)(bb + 1024), bl1 = *(const f32x4*)(bb + 1028);
        const int row0 = u.pm * BM + wr * 64 + fr;
#pragma unroll
        for (int ai = 0; ai < 2; ++ai)
#pragma unroll
            for (int m = 0; m < 4; ++m) {
                constexpr float dq = 1.0f / (SC_HN * SC_W);
                const f32x4 g0 = acc[ai][0][m][0] * dq + bg0, g1 = acc[ai][0][m][1] * dq + bg1, l0 = acc[ai][1][m][0] * dq + bl0, l1 = acc[ai][1][m][1] * dq + bl1;
                f32x4 a0, a1;
#pragma unroll
                for (int e = 0; e < 4; ++e) {
                    const float ga = fminf(g0[e], SW_LIMIT), la = fminf(fmaxf(l0[e], -SW_LIMIT), SW_LIMIT); a0[e] = ga * sigmoidf_(SW_ALPHA * ga) * (la + 1.0f);
                    const float gb = fminf(g1[e], SW_LIMIT), lb = fminf(fmaxf(l1[e], -SW_LIMIT), SW_LIMIT); a1[e] = gb * sigmoidf_(SW_ALPHA * gb) * (lb + 1.0f); }
                u32x2 w; w.x = pack4_fp8(a0[0] * SC_ACT, a0[1] * SC_ACT, a0[2] * SC_ACT, a0[3] * SC_ACT); w.y = pack4_fp8(a1[0] * SC_ACT, a1[1] * SC_ACT, a1[2] * SC_ACT, a1[3] * SC_ACT);
                *(u32x2*)(ACT + (size_t)(row0 + ai * HALF + m * 16) * DE + c0) = w;
            }
    }
};
struct EpiDown {
    static constexpr bool PERM = true, FP8 = true;
    unsigned char* Y; const float* bdn; const float* rgate;
    __device__ __forceinline__ void operator()(const f32x4 (&acc)[2][2][4][2], const Unit& u, int wr, int wc, int fr, int fq) const {
        const int c0 = u.pn * BM + wc * 32 + 8 * fq;
        const float* bb = bdn + (size_t)u.e * DM + c0;
        f32x4 bv[2][2];
#pragma unroll
        for (int bj = 0; bj < 2; ++bj)
#pragma unroll
            for (int n = 0; n < 2; ++n) bv[bj][n] = *(const f32x4*)(bb + bj * HALF + 4 * n);
        const int lrow0 = wr * 64 + fr;
        const float* gp = rgate + (size_t)u.e * CAP + u.rt * BM;
#pragma unroll
        for (int ai = 0; ai < 2; ++ai)
#pragma unroll
            for (int m = 0; m < 4; ++m) {
                const int lr = lrow0 + ai * HALF + m * 16; const float gt = gp[lr] * SC_Y;
                unsigned char* rowp = Y + (size_t)(u.pm * BM + lr) * DM + c0;
#pragma unroll
                for (int bj = 0; bj < 2; ++bj) { constexpr float dq = 1.0f / (SC_ACT * SC_W); const f32x4 v0 = (acc[ai][bj][m][0] * dq + bv[bj][0]) * gt, v1 = (acc[ai][bj][m][1] * dq + bv[bj][1]) * gt;
                    u32x2 w; w.x = pack4_fp8(v0[0], v0[1], v0[2], v0[3]); w.y = pack4_fp8(v1[0], v1[1], v1[2], v1[3]);
                    *(u32x2*)(rowp + bj * HALF) = w; }
            }
    }
};
}

struct Frame {
    LAS unsigned char* lds; LAS unsigned char* aux;
    gu32* ctl;
    int tid, lane, wave, vcu, G;
    const float *x, *meta, *g1, *w_in, *qg, *kg, *conv_w, *conv_b, *ln_g, *ln_b, *og, *w_out, *g2, *w_r, *b_r, *w_up, *b_up, *w_dn, *b_dn;
    float* out;
    bf16 *WinT, *WoT, *NM, *Q, *Kh, *VT, *HCV;
    unsigned char *WdT, *WupT, *HN, *ACT, *Y;
    int* rtok; float* rgate; unsigned* tslot; unsigned char* rfrag;
};

__device__ __forceinline__ int win_dest(int n0) {
    if (n0 < 1536) { const int tile = n0 >> 8, s = n0 & 255, wc = s >> 6, bj = (s >> 5) & 1; return tile * 256 + 128 * bj + 32 * wc; }
    if (n0 < 2048) { const int j = n0 - 1536; return 1536 + 256 * (j >> 7) + (j & 127); }
    const int j = n0 - 2048; return 1536 + 256 * (j >> 7) + 128 + (j & 127);
}
__device__ __forceinline__ int wup_dest(int n0) { if (n0 < 1024) return 256 * (n0 >> 7) + (n0 & 127); const int j = n0 - 1024; return 256 * (j >> 7) + 128 + (j & 127); }
struct TrItem { const float* src; const float* g; void* dst; int N; int f8; };
__device__ __forceinline__ void tr_load(const TrItem& t, f32x4 (&v)[8], float (&gv)[8], int lane) {
    const int kr = lane >> 3, nc = (lane & 7) * 4;
#pragma unroll
    for (int i = 0; i < 8; ++i) { v[i] = *(const f32x4*)(t.src + (size_t)(8 * i + kr) * t.N + nc); gv[i] = t.g ? t.g[8 * i + kr] : 1.0f; }
}
__device__ __forceinline__ void tr_store(const TrItem& t, const f32x4 (&v)[8], const float (&gv)[8], LAS float* scr, int lane) {
    const int kr = lane >> 3, nc = (lane & 7) * 4;
#pragma unroll
    for (int i = 0; i < 8; ++i) { LAS float* d = scr + (8 * i + kr) * 33 + nc; d[0] = v[i].x * gv[i]; d[1] = v[i].y * gv[i]; d[2] = v[i].z * gv[i]; d[3] = v[i].w * gv[i]; }
    LDS_WAIT(); asm volatile("" ::: "memory");
    const int c = lane & 7;
#pragma unroll
    for (int j = 0; j < 4; ++j) { const int n = (lane >> 3) + 8 * j; const LAS float* q = scr + (8 * c) * 33 + n;
        if (t.f8) { u32x2 o; o.x = pack4_fp8(q[0 * 33] * SC_W, q[1 * 33] * SC_W, q[2 * 33] * SC_W, q[3 * 33] * SC_W); o.y = pack4_fp8(q[4 * 33] * SC_W, q[5 * 33] * SC_W, q[6 * 33] * SC_W, q[7 * 33] * SC_W);
            *(u32x2*)((unsigned char*)t.dst + (size_t)n * 1024 + 8 * c) = o; }
        else { u32x4 o; o.x = cvt_pk_bf16(q[0 * 33], q[1 * 33]); o.y = cvt_pk_bf16(q[2 * 33], q[3 * 33]); o.z = cvt_pk_bf16(q[4 * 33], q[5 * 33]); o.w = cvt_pk_bf16(q[6 * 33], q[7 * 33]);
            *(u32x4*)((bf16*)t.dst + (size_t)n * 1024 + 8 * c) = o; } }
    LDS_WAIT(); asm volatile("" ::: "memory");
}
__device__ __forceinline__ void meta_unit(Frame& F, int mu) {
    LAS float* nmT = (LAS float*)F.lds;
    LAS float* part = (LAS float*)(F.lds + 65536);
    LAS float* rs = (LAS float*)(F.aux + A_RED);
    const int type = mu >> 3, hh = mu & 7, lane = F.lane, w = F.wave;
    for (int r = 2 * w; r < 2 * w + 2; ++r) { float s = 0.f; for (int k = lane; k < DM; k += 64) { const float v = F.meta[r * DM + k]; s += v * v; } s = wave_sum(s); if (lane == 0) rs[r] = __builtin_amdgcn_rsqf(s * (1.0f / DM) + EPS); }
    __syncthreads();
    for (int idx = F.tid; idx < NMETA * DM; idx += 512) { const int r = idx >> 10, k = idx & 1023; nmT[k * 16 + r] = F.meta[idx] * rs[r] * F.g1[k]; }
    __syncthreads();
    const int col = (type == 0 ? 512 : type == 1 ? 1024 : 1536) + 64 * hh + lane, colg = 2048 + 64 * hh + lane;
    float a1[16], a2[16];
#pragma unroll
    for (int r = 0; r < 16; ++r) { a1[r] = 0.f; a2[r] = 0.f; }
    for (int k0 = 128 * w; k0 < 128 * w + 128; k0 += 16) {
        float wv[16], wg[16];
#pragma unroll
        for (int i = 0; i < 16; ++i) { wv[i] = F.w_in[(size_t)(k0 + i) * INC + col]; wg[i] = (type == 2) ? F.w_in[(size_t)(k0 + i) * INC + colg] : 0.f; }
#pragma unroll
        for (int i = 0; i < 16; ++i) {
            const LAS f32x4* np = (const LAS f32x4*)(nmT + (k0 + i) * 16);
#pragma unroll
            for (int q = 0; q < 4; ++q) { const f32x4 nv = np[q];
#pragma unroll
                for (int e = 0; e < 4; ++e) { a1[4 * q + e] += nv[e] * wv[i]; a2[4 * q + e] += nv[e] * wg[i]; } }
        }
    }
#pragma unroll
    for (int r = 0; r < 16; ++r) { part[(w * 16 + r) * 64 + lane] = a1[r]; part[8192 + (w * 16 + r) * 64 + lane] = a2[r]; }
    __syncthreads();
    for (int r = 2 * w; r < 2 * w + 2; ++r) {
        float v = 0.f, v2 = 0.f;
#pragma unroll
        for (int ww = 0; ww < 8; ++ww) { v += part[(ww * 16 + r) * 64 + lane]; v2 += part[8192 + (ww * 16 + r) * 64 + lane]; }
        if (type == 0) { const float ss = wave_sum(v * v); const bf16 o = f2bf(v * __builtin_amdgcn_rsqf(ss * (1.0f / 64.0f) + EPS) * F.kg[lane]);
            for (int b = 0; b < NB; ++b) F.Kh[((size_t)(b * NH + hh) * LP + LPAD + r) * HD + lane] = o; }
        else if (type == 1) { const bf16 o = f2bf(v); for (int b = 0; b < NB; ++b) F.VT[((size_t)(b * NH + hh) * HD + lane) * LP + LPAD + r] = o; }
        else { const bf16 o = f2bf(v * sigmoidf_(v2)); for (int b = 0; b < NB; ++b) F.HCV[((size_t)b * LP + LPAD + r) * CW + 64 * hh + lane] = o; }
    }
    __syncthreads();
}
template <int PARTS> __device__ __forceinline__ void p0_prologue(Frame& F) {
    if (PARTS & 1) { if (F.vcu < 24) meta_unit(F, F.vcu);
    for (int mu = F.vcu + F.G; mu < 24; mu += F.G) meta_unit(F, mu); }
    LAS float* scr = (LAS float*)(F.lds + F.wave * 16384);
    const int gw = F.vcu * NWAVES + F.wave, NGW = F.G * NWAVES, lane = F.lane;
    if (PARTS & 1) for (int it = gw; it < 64; it += NGW) {
#pragma unroll
        for (int i = 0; i < 8; ++i) { const int idx = 512 * it + 64 * i + lane, k = idx >> 5, e = idx & 31; const float w = F.w_r[idx] * F.g2[k];
            const bf16 hi = f2bf(w), lo = f2bf(w - bf2f(hi));
            const int off = (((k >> 5) * 2 + (e >> 4)) * 2) * 1024 + ((((k >> 3) & 3) * 16 + (e & 15)) * 16) + (k & 7) * 2;
            *(bf16*)(F.rfrag + off) = hi; *(bf16*)(F.rfrag + off + 1024) = lo; }
    }
    if (PARTS & 1) for (int it = gw; it < 192; it += NGW) {
        const u32x4 z = (u32x4){0u, 0u, 0u, 0u};
        if (it < 64) { u32x4* p = (u32x4*)(F.Kh + (size_t)it * LP * HD); p[lane] = z; p[64 + lane] = z; }
        else if (it < 128) { u32x4* p = (u32x4*)(F.VT + ((size_t)(it - 64) * HD + lane) * LP); p[0] = z; p[1] = z; }
        else { const int j = it - 128, b = j >> 3, rr = (j & 7) * 2; u32x4* p = (u32x4*)(F.HCV + ((size_t)b * LP + rr) * CW); p[lane] = z; p[64 + lane] = z; }
    }
    constexpr int I_IN = 16 * 80, I_O = 16 * 32, I_UP = NE * 16 * 64, I_DN = NE * 16 * 32, NITEMS = I_IN + I_O + I_UP + I_DN;
    auto decode = [&](int it, TrItem& t) {
        int r = it;
        if (r < I_IN) { const int kb = r / 80, nb = r % 80; t.src = F.w_in + (size_t)(64 * kb) * INC + 32 * nb; t.N = INC; t.g = F.g1 + 64 * kb; t.dst = F.WinT + (size_t)win_dest(32 * nb) * 1024 + 64 * kb; t.f8 = 0; return; } r -= I_IN;
        if (r < I_O) { const int kb = r / 32, nb = r % 32; t.src = F.w_out + (size_t)(64 * kb) * DM + 32 * nb; t.N = DM; t.g = nullptr; t.dst = F.WoT + (size_t)(32 * nb) * 1024 + 64 * kb; t.f8 = 0; return; } r -= I_O;
        if (r < I_UP) { const int e = r >> 10, rr = r & 1023, kb = rr >> 6, nb = rr & 63; t.src = F.w_up + (size_t)e * DM * 2048 + (size_t)(64 * kb) * 2048 + 32 * nb; t.N = 2048; t.g = F.g2 + 64 * kb;
            t.dst = F.WupT + ((size_t)e * 2048 + wup_dest(32 * nb)) * 1024 + 64 * kb; t.f8 = 1; return; } r -= I_UP;
        { const int e = r >> 9, rr = r & 511, kb = rr >> 5, nb = rr & 31; t.src = F.w_dn + (size_t)e * DE * DM + (size_t)(64 * kb) * DM + 32 * nb; t.N = DM; t.g = nullptr;
            t.dst = F.WdT + ((size_t)e * DM + 32 * nb) * 1024 + 64 * kb; t.f8 = 1; }
    };
    if (PARTS & 2) {
        constexpr int META_CREDIT = 4;
        const int nmw = (F.G > 24 ? 24 : 0) * NWAVES, N1 = NITEMS - META_CREDIT * nmw, q1 = (N1 - gw + NGW - 1) / NGW;
        auto seq = [&](int q) -> int { if (q < q1) return gw + q * NGW; if (gw < nmw) return NITEMS; return N1 + (gw - nmw) + (q - q1) * (NGW - nmw); };
        TrItem t0, t1, t2; f32x4 va[8], vb[8], vc[8]; float ga[8], gb[8], gc[8];
        int q = 0, i0 = seq(0), i1 = seq(1);
        if (i0 < NITEMS) { decode(i0, t0); tr_load(t0, va, ga, lane); }
        if (i1 < NITEMS) { decode(i1, t1); tr_load(t1, vb, gb, lane); }
        while (i0 < NITEMS) {
            const int i2 = seq(q + 2);
            if (i2 < NITEMS) { decode(i2, t2); tr_load(t2, vc, gc, lane); }
            tr_store(t0, va, ga, scr, lane);
            t0 = t1; t1 = t2; i0 = i1; i1 = i2; ++q;
#pragma unroll
            for (int i = 0; i < 8; ++i) { va[i] = vb[i]; ga[i] = gb[i]; vb[i] = vc[i]; gb[i] = gc[i]; }
        }
    }
    if (PARTS & 4) for (int m = gw; m < NTOK; m += 4 * NGW) {
        f32x4 v[4][4]; float ss[4];
#pragma unroll
        for (int r = 0; r < 4; ++r) { const int mr = (m + r * NGW < NTOK) ? m + r * NGW : m; const f32x4* xr = (const f32x4*)(F.x + (size_t)mr * DM) + lane;
#pragma unroll
            for (int j = 0; j < 4; ++j) v[r][j] = xr[64 * j]; }
#pragma unroll
        for (int r = 0; r < 4; ++r) { float q = 0.f;
#pragma unroll
            for (int j = 0; j < 4; ++j) q += (v[r][j].x * v[r][j].x + v[r][j].y * v[r][j].y) + (v[r][j].z * v[r][j].z + v[r][j].w * v[r][j].w);
            ss[r] = __builtin_amdgcn_rsqf(wave_sum(q) * (1.0f / DM) + EPS); }
#pragma unroll
        for (int r = 0; r < 4; ++r) { const int mr = (m + r * NGW < NTOK) ? m + r * NGW : m; u32x2* o8 = (u32x2*)(F.NM + (size_t)mr * DM) + lane;
#pragma unroll
            for (int j = 0; j < 4; ++j) { u32x2 o; o.x = cvt_pk_bf16(v[r][j].x * ss[r], v[r][j].y * ss[r]); o.y = cvt_pk_bf16(v[r][j].z * ss[r], v[r][j].w * ss[r]); o8[64 * j] = o; } }
    }
}

__device__ __forceinline__ void conv_phase(Frame& F) {
    const int c = F.tid, lane = F.lane;
    LAS float* red = (LAS float*)(F.aux + A_RED); LAS float* tot = (LAS float*)(F.aux + A_TOT);
    float w[CKW];
#pragma unroll
    for (int j = 0; j < CKW; ++j) w[j] = F.conv_w[j * CW + c];
    const float cb = F.conv_b[c], lg = F.ln_g[c], lb = F.ln_b[c];
    for (int u = F.vcu; u < NTOK / 16; u += F.G) {
        const int t0 = u * 16, b = t0 >> 12, tb = t0 & 4095;
        const bf16* hp = F.HCV + ((size_t)b * LP + tb + 2) * CW + c;
        float h[46];
#pragma unroll
        for (int i = 0; i < 46; ++i) h[i] = bf2f(hp[(size_t)i * CW]);
        float v[16], rr[32];
#pragma unroll
        for (int j = 0; j < 16; ++j) { float s = cb;
#pragma unroll
            for (int k = 0; k < CKW; ++k) s += w[k] * h[j + k];
            v[j] = s; rr[j] = s; rr[16 + j] = s * s; }
        wave_reduce32(rr);
        if ((lane & 15) == 0) {
#pragma unroll
            for (int i = 0; i < 8; ++i) red[F.wave * 32 + 8 * (lane >> 4) + i] = rr[i]; }
        __syncthreads();
        if (F.tid < 32) { float s = 0.f;
#pragma unroll
            for (int ww = 0; ww < 8; ++ww) s += red[ww * 32 + F.tid]; tot[F.tid] = s; }
        __syncthreads();
#pragma unroll
        for (int j = 0; j < 16; ++j) { const float mean = tot[j] * (1.0f / CW), var = fmaxf(tot[16 + j] * (1.0f / CW) - mean * mean, 0.f);
            const float y = (v[j] - mean) * __builtin_amdgcn_rsqf(var + EPS) * lg + lb;
            F.NM[(size_t)(t0 + j) * DM + SBW + c] = f2bf(y * sigmoidf_(y)); }
    }
}

template <bool EARLY>
__device__ __forceinline__ void attn_wave_unit(Frame& F, int bh, int qb, LAS float* stg) {
    const int lane = F.lane, r = lane & 31, hf = lane >> 5;
    const bf16* qp = F.Q + ((size_t)bh * SEQ + qb * 32 + r) * HD + 8 * hf;
    bf16x8 qf[4];
#pragma unroll
    for (int s = 0; s < 4; ++s) qf[s] = *(const bf16x8*)(qp + 16 * s);
    const int krow = (r & ~12) | ((r & 4) << 1) | ((r & 8) >> 1);
    const bf16* kp = F.Kh + ((size_t)bh * LP + krow) * HD + 8 * hf;
    const bf16* vp = F.VT + ((size_t)bh * HD + r) * LP + 8 * hf;
    f32x16 o0, o1;
#pragma unroll
    for (int i = 0; i < 16; ++i) { o0[i] = 0.f; o1[i] = 0.f; }
    float C = 1.0f;
    int jb = qb + 1;
    bf16x8 kf[4], vf[4], kn[4], vn[4];
#define LOADKV(KF, VF, J) do { _Pragma("unroll") for (int s = 0; s < 4; ++s) KF[s] = *(const bf16x8*)(kp + (size_t)(J) * 32 * HD + 16 * s); \
        _Pragma("unroll") for (int d = 0; d < 2; ++d) _Pragma("unroll") for (int s = 0; s < 2; ++s) VF[d * 2 + s] = *(const bf16x8*)(vp + (size_t)d * 32 * LP + (J) * 32 + 16 * s); } while (0)
    LOADKV(kf, vf, jb);
    for (;;) {
        const int jn = jb > 0 ? jb - 1 : 0;
        LOADKV(kn, vn, jn);
        f32x16 st;
#pragma unroll
        for (int i = 0; i < 16; ++i) st[i] = 0.f;
#pragma unroll
        for (int s = 0; s < 4; ++s) st = __builtin_amdgcn_mfma_f32_32x32x16_bf16(kf[s], qf[s], st, 0, 0, 0);
        const bool diag = (jb == qb + 1), first = (jb == 0);
        float be[16], ke[16];
#pragma unroll
        for (int i = 0; i < 16; ++i) {
            const int c = 16 * (i >> 3) + 8 * hf + (i & 7);
            const float u = fast_exp2(-st[i]);
            const float bt = fast_rcp(1.0f + u);
            const bool valid = diag ? (c < r) : (first ? (c >= 16) : true);
            be[i] = valid ? bt : 0.f; ke[i] = valid ? u * bt : 1.0f;
        }
        float plo = ke[0], phi = ke[8];
#pragma unroll
        for (int i = 1; i < 8; ++i) { plo *= ke[i]; phi *= ke[8 + i]; }
        const float plo_o = __shfl_xor(plo, 32), phi_o = __shfl_xor(phi, 32);
        const float X1 = phi * phi_o, X0 = plo * plo_o, CX1 = C * X1;
        float run = hf ? C : C * phi_o;
        float a[16];
#pragma unroll
        for (int i = 15; i >= 8; --i) { a[i] = be[i] * run; run *= ke[i]; }
        run = hf ? CX1 : CX1 * plo_o;
#pragma unroll
        for (int i = 7; i >= 0; --i) { a[i] = be[i] * run; run *= ke[i]; }
        C = CX1 * X0;
        u32x4 p0, p1;
        p0.x = cvt_pk_bf16(a[0], a[1]); p0.y = cvt_pk_bf16(a[2], a[3]); p0.z = cvt_pk_bf16(a[4], a[5]); p0.w = cvt_pk_bf16(a[6], a[7]);
        p1.x = cvt_pk_bf16(a[8], a[9]); p1.y = cvt_pk_bf16(a[10], a[11]); p1.z = cvt_pk_bf16(a[12], a[13]); p1.w = cvt_pk_bf16(a[14], a[15]);
        const bf16x8 af0 = __builtin_bit_cast(bf16x8, p0), af1 = __builtin_bit_cast(bf16x8, p1);
        o0 = __builtin_amdgcn_mfma_f32_32x32x16_bf16(af0, vf[0], o0, 0, 0, 0); o0 = __builtin_amdgcn_mfma_f32_32x32x16_bf16(af1, vf[1], o0, 0, 0, 0);
        o1 = __builtin_amdgcn_mfma_f32_32x32x16_bf16(af0, vf[2], o1, 0, 0, 0); o1 = __builtin_amdgcn_mfma_f32_32x32x16_bf16(af1, vf[3], o1, 0, 0, 0);
        if (jb == 0) break;
        if (EARLY) { if (__all(C < ATTN_CUT)) break; }
        --jb;
#pragma unroll
        for (int s = 0; s < 4; ++s) { kf[s] = kn[s]; vf[s] = vn[s]; }
    }
#undef LOADKV
#pragma unroll
    for (int i = 0; i < 16; ++i) { const int q = (i & 3) + 8 * (i >> 2) + 4 * hf; stg[q * 68 + r] = o0[i]; stg[q * 68 + 32 + r] = o1[i]; }
    LDS_WAIT(); asm volatile("" ::: "memory");
    const int q = lane >> 1, half = lane & 1, h = bh & 7, b = bh >> 3;
    f32x4 v[8]; float ss = 0.f;
#pragma unroll
    for (int j = 0; j < 8; ++j) { v[j] = *(const LAS f32x4*)(stg + q * 68 + 32 * half + 4 * j); ss += (v[j].x * v[j].x + v[j].y * v[j].y) + (v[j].z * v[j].z + v[j].w * v[j].w); }
    ss += __shfl_xor(ss, 1);
    const float rstd = __builtin_amdgcn_rsqf(ss * (1.0f / 64.0f) + EPS);
    const float* gp = F.og + h * HD + 32 * half;
    bf16* dst = F.NM + ((size_t)(b * SEQ + qb * 32 + q)) * DM + h * HD + 32 * half;
#pragma unroll
    for (int j = 0; j < 4; ++j) { const f32x4 g0 = *(const f32x4*)(gp + 8 * j), g1 = *(const f32x4*)(gp + 8 * j + 4); const f32x4 a0 = v[2 * j] * rstd * g0, a1 = v[2 * j + 1] * rstd * g1;
        u32x4 w; w.x = cvt_pk_bf16(a0[0], a0[1]); w.y = cvt_pk_bf16(a0[2], a0[3]); w.z = cvt_pk_bf16(a1[0], a1[1]); w.w = cvt_pk_bf16(a1[2], a1[3]);
        *(u32x4*)(dst + 8 * j) = w; }
    LDS_WAIT(); asm volatile("" ::: "memory");
}
__device__ __forceinline__ void attn_phase(Frame& F) {
    LAS float* stg = (LAS float*)(F.lds + F.wave * 8704);
    for (int wu = F.vcu; wu < 64 * 16; wu += F.G) {
        const int bh = wu & 63, j = wu >> 6;
        const int i = j >> 2, j0 = j & 3;
        const int grp = (i == 0) ? j0 : (i == 1) ? 15 - j0 : (i == 2) ? 4 + j0 : 11 - j0;
        attn_wave_unit<ATTN_EARLY != 0>(F, bh, grp * 8 + F.wave, stg);
    }
}

template <int MODE> __device__ __forceinline__ void router_phase(Frame& F, const bool commit) {
    LAS unsigned char* WF = F.lds;
    LAS int* hist = (LAS int*)(F.aux + A_HIST); LAS int* base = (LAS int*)(F.aux + A_BASE);
    LAS int* sel_e = (LAS int*)(F.aux + A_SELE); LAS float* sel_g = (LAS float*)(F.aux + A_SELG); LAS int* rank = (LAS int*)(F.aux + A_RANK);
    LAS float* rsw = (LAS float*)(F.aux + A_RED) + F.wave * 16;
    const int lane = F.lane, fr = lane & 15, fq = lane >> 4;
    { u32x4 t[16];
#pragma unroll
      for (int i = 0; i < 16; ++i) t[i] = *(const u32x4*)(F.rfrag + (size_t)(i * 512 + F.tid) * 16);
#pragma unroll
      for (int i = 0; i < 16; ++i) *(LAS u32x4*)(WF + (size_t)(i * 512 + F.tid) * 16) = t[i]; }
    __syncthreads();
    const float br0 = F.b_r[fr], br1 = F.b_r[fr + 16];
    for (int blk = F.vcu; blk < NTOK / 128; blk += F.G) {
        if (F.tid < 32) hist[F.tid] = 0;
        const int t0 = blk * 128 + F.wave * 16;
        const float* xrow = F.out + (size_t)(t0 + fr) * DM + 8 * fq;
        f32x4 q0 = (f32x4){0.f, 0.f, 0.f, 0.f}, q1 = q0, q2 = q0, q3 = q0, q4 = q0, q5 = q0; float ssq = 0.f;
#define RT_MFMA(ACC, A, B) asm volatile("v_mfma_f32_16x16x32_bf16 %0, %1, %2, %0" : "+v"(ACC) : "v"(A), "v"(B))
        f32x4 xa[8][2], xb[8][2];
#pragma unroll
        for (int i = 0; i < 8; ++i) { xa[i][0] = *(const f32x4*)(xrow + 32 * i); xa[i][1] = *(const f32x4*)(xrow + 32 * i + 4); }
#pragma unroll 1
        for (int c = 0; c < 4; ++c) {
            const int cn = (c + 1 < 4) ? c + 1 : c;
#pragma unroll
            for (int i = 0; i < 8; ++i) { xb[i][0] = *(const f32x4*)(xrow + 256 * cn + 32 * i); xb[i][1] = *(const f32x4*)(xrow + 256 * cn + 32 * i + 4); }
#pragma unroll
            for (int i = 0; i < 8; ++i) {
                const f32x4 u = xa[i][0], v = xa[i][1];
                ssq += (u.x * u.x + u.y * u.y) + (u.z * u.z + u.w * u.w) + (v.x * v.x + v.y * v.y) + (v.z * v.z + v.w * v.w);
                u32x4 ph, pl;
                ph.x = cvt_pk_bf16(u.x, u.y); ph.y = cvt_pk_bf16(u.z, u.w); ph.z = cvt_pk_bf16(v.x, v.y); ph.w = cvt_pk_bf16(v.z, v.w);
                pl.x = cvt_pk_bf16(u.x - __uint_as_float(ph.x << 16), u.y - __uint_as_float(ph.x & 0xffff0000u)); pl.y = cvt_pk_bf16(u.z - __uint_as_float(ph.y << 16), u.w - __uint_as_float(ph.y & 0xffff0000u));
                pl.z = cvt_pk_bf16(v.x - __uint_as_float(ph.z << 16), v.y - __uint_as_float(ph.z & 0xffff0000u)); pl.w = cvt_pk_bf16(v.z - __uint_as_float(ph.w << 16), v.w - __uint_as_float(ph.w & 0xffff0000u));
                const bf16x8 ah = __builtin_bit_cast(bf16x8, ph), al = __builtin_bit_cast(bf16x8, pl);
                const LAS unsigned char* wf = WF + (size_t)((8 * c + i) * 4) * 1024 + lane * 16;
                const bf16x8 bh0 = *(const LAS bf16x8*)(wf), bl0 = *(const LAS bf16x8*)(wf + 1024), bh1 = *(const LAS bf16x8*)(wf + 2048), bl1 = *(const LAS bf16x8*)(wf + 3072);
                RT_MFMA(q0, ah, bh0); RT_MFMA(q1, ah, bh1); RT_MFMA(q2, ah, bl0); RT_MFMA(q3, ah, bl1); RT_MFMA(q4, al, bh0); RT_MFMA(q5, al, bh1);
            }
#pragma unroll
            for (int i = 0; i < 8; ++i) { xa[i][0] = xb[i][0]; xa[i][1] = xb[i][1]; }
        }
#undef RT_MFMA
        asm volatile("s_nop 15\n\ts_nop 7" : "+v"(q0), "+v"(q1), "+v"(q2), "+v"(q3), "+v"(q4), "+v"(q5));
        const f32x4 acc0 = (q0 + q2) + q4, acc1 = (q1 + q3) + q5;
        ssq = swap16_sum(ssq, ssq); ssq = swap32_sum(ssq, ssq);
        const float rstd_fr = __builtin_amdgcn_rsqf(ssq * (1.0f / DM) + EPS);
        if (fq == 0) rsw[fr] = rstd_fr;
        LDS_WAIT(); asm volatile("" ::: "memory");
        const f32x4 rs4 = *(const LAS f32x4*)(rsw + 4 * fq);
#pragma unroll
        for (int r = 0; r < 4; ++r) {
            float v0 = acc0[r] * rs4[r] + br0, v1 = acc1[r] * rs4[r] + br1;
            int se[4]; float sv[4];
#pragma unroll
            for (int k = 0; k < 4; ++k) {
                float bv = v0; int bi = fr; if (v1 > v0) { bv = v1; bi = fr + 16; }
#define RT_STEP(CTRL) do { const float ov_ = dpp_f<CTRL>(bv); const int oi_ = dpp_i<CTRL>(bi); if (ov_ > bv || (ov_ == bv && oi_ < bi)) { bv = ov_; bi = oi_; } } while (0)
                RT_STEP(DPP_ROW_MIRROR); RT_STEP(DPP_ROW_HALF_MIRROR); RT_STEP(DPP_QUAD_REV); RT_STEP(DPP_QUAD_SWAP);
#undef RT_STEP
                se[k] = bi; sv[k] = bv; if (bi == fr) v0 = -INFINITY; if (bi == fr + 16) v1 = -INFINITY;
            }
            const float e1 = __expf(sv[1] - sv[0]), e2 = __expf(sv[2] - sv[0]), e3 = __expf(sv[3] - sv[0]); const float inv = 1.0f / (1.0f + e1 + e2 + e3);
            if (fr == 0) { const int tl = F.wave * 16 + 4 * fq + r;
                sel_e[tl * 4 + 0] = se[0]; sel_e[tl * 4 + 1] = se[1]; sel_e[tl * 4 + 2] = se[2]; sel_e[tl * 4 + 3] = se[3];
                sel_g[tl * 4 + 0] = inv; sel_g[tl * 4 + 1] = e1 * inv; sel_g[tl * 4 + 2] = e2 * inv; sel_g[tl * 4 + 3] = e3 * inv; }
        }
        for (int r0 = 0; r0 < 16; r0 += 4) {
            f32x4 xv[4][4]; const f32x4 rq4 = *(const LAS f32x4*)(rsw + r0);
#pragma unroll
            for (int r = 0; r < 4; ++r) { const f32x4* xr = (const f32x4*)(F.out + (size_t)(t0 + r0 + r) * DM) + lane;
#pragma unroll
                for (int j = 0; j < 4; ++j) xv[r][j] = xr[64 * j]; }
#pragma unroll
            for (int r = 0; r < 4; ++r) { unsigned* o8 = (unsigned*)(F.HN + (size_t)(t0 + r0 + r) * DM) + lane; const float rq = rq4[r] * SC_HN;
#pragma unroll
                for (int j = 0; j < 4; ++j) o8[64 * j] = pack4_fp8(xv[r][j].x * rq, xv[r][j].y * rq, xv[r][j].z * rq, xv[r][j].w * rq); }
        }
        __syncthreads();
        const int a = F.tid, ea = sel_e[a];
        rank[a] = __hip_atomic_fetch_add(hist + ea, 1, __ATOMIC_RELAXED, __HIP_MEMORY_SCOPE_WORKGROUP);
        __syncthreads();
        if (F.tid < 32 && commit) base[F.tid] = (int)__hip_atomic_fetch_add((unsigned*)(F.ctl + CW_CNT + 64 * F.tid), (unsigned)hist[F.tid], RLX_AGENT);
        __syncthreads();
        if (commit) { const int pos = base[ea] + rank[a], t = blk * 128 + (a >> 2);
          F.rtok[(size_t)ea * CAP + pos] = t; F.rgate[(size_t)ea * CAP + pos] = sel_g[a]; F.tslot[(size_t)t * 4 + (a & 3)] = ((unsigned)ea << 16) | (unsigned)pos; }
        __syncthreads();
    }
}

__device__ __forceinline__ void moe_setup(Frame& F) {
    LAS int* tpre = (LAS int*)(F.aux + A_TPRE); LAS int* cnt = (LAS int*)(F.aux + A_CNT);
    if (F.tid < 32) cnt[F.tid] = (int)__hip_atomic_load((unsigned*)(F.ctl + CW_CNT + 64 * F.tid), RLX_AGENT);
    __syncthreads();
    if (F.tid == 0) { int s = 0; for (int e = 0; e < NE; ++e) { tpre[e] = s; s += (cnt[e] + 255) >> 8; } tpre[NE] = s; }
    __syncthreads();
}

__device__ __forceinline__ void combine_phase(Frame& F, float* dstbase) {
    const LAS int* tpre = (const LAS int*)(F.aux + A_TPRE);
    const int gw = F.vcu * NWAVES + F.wave, NGW = F.G * NWAVES, lane = F.lane;
    constexpr float ys = 1.0f / SC_Y;
    for (int t = gw; t < NTOK; t += 2 * NGW) {
        const int t2 = (t + NGW < NTOK) ? t + NGW : t;
        const u32x4 sa = *(const u32x4*)(F.tslot + (size_t)t * 4), sb = *(const u32x4*)(F.tslot + (size_t)t2 * 4);
        const f32x4* orow = (const f32x4*)(F.out + (size_t)t * DM) + lane; const f32x4* orow2 = (const f32x4*)(F.out + (size_t)t2 * DM) + lane;
        f32x4 v[4], w[4];
#pragma unroll
        for (int j = 0; j < 4; ++j) { v[j] = orow[64 * j]; w[j] = orow2[64 * j]; }
        unsigned ya[4][4], yb[4][4];
#pragma unroll
        for (int k = 0; k < 4; ++k) {
            const unsigned s1 = sa[k], s2 = sb[k];
            const unsigned* y1 = (const unsigned*)(F.Y + ((size_t)tpre[s1 >> 16] * 256 + (s1 & 0xffffu)) * DM) + lane;
            const unsigned* y2 = (const unsigned*)(F.Y + ((size_t)tpre[s2 >> 16] * 256 + (s2 & 0xffffu)) * DM) + lane;
#pragma unroll
            for (int j = 0; j < 4; ++j) { ya[k][j] = y1[64 * j]; yb[k][j] = y2[64 * j]; }
        }
#pragma unroll
        for (int j = 0; j < 4; ++j) {
            f32x4 sa4 = (f32x4){0.f, 0.f, 0.f, 0.f}, sb4 = sa4;
#pragma unroll
            for (int k = 0; k < 4; ++k) {
                const f32x2 a0 = __builtin_amdgcn_cvt_pk_f32_fp8((int)ya[k][j], false), a1 = __builtin_amdgcn_cvt_pk_f32_fp8((int)ya[k][j], true);
                const f32x2 b0 = __builtin_amdgcn_cvt_pk_f32_fp8((int)yb[k][j], false), b1 = __builtin_amdgcn_cvt_pk_f32_fp8((int)yb[k][j], true);
                sa4.x += a0.x; sa4.y += a0.y; sa4.z += a1.x; sa4.w += a1.y; sb4.x += b0.x; sb4.y += b0.y; sb4.z += b1.x; sb4.w += b1.y; }
            v[j] += sa4 * ys; w[j] += sb4 * ys;
        }
#pragma unroll
        for (int j = 0; j < 4; ++j) ((f32x4*)(dstbase + (size_t)t * DM) + lane)[64 * j] = v[j];
        if (t2 != t) {
#pragma unroll
            for (int j = 0; j < 4; ++j) ((f32x4*)(dstbase + (size_t)t2 * DM) + lane)[64 * j] = w[j]; }
    }
}

struct Args { const float* in[19]; float* out; unsigned char* ws; int ph_lo, ph_hi; };
template <int PLO, int PHI> __global__ void __launch_bounds__(NWAVES * 64, 2) hymba_fwd(Args args) {
    extern __shared__ __attribute__((aligned(16))) unsigned char lds[];
    Frame F;
    F.lds = (LAS unsigned char*)lds; F.aux = F.lds + AUX_OFF;
    F.tid = threadIdx.x; F.lane = F.tid & 63; F.wave = __builtin_amdgcn_readfirstlane(F.tid >> 6);
    F.G = gridDim.x; { const int bx = blockIdx.x; F.vcu = (F.G % 8 == 0) ? (bx % 8) * (F.G / 8) + bx / 8 : bx; }
    unsigned char* ws = args.ws;
    F.ctl = (gu32*)(ws + WS_CTL);
    F.x = args.in[0]; F.meta = args.in[1]; F.g1 = args.in[2]; F.w_in = args.in[3]; F.qg = args.in[4]; F.kg = args.in[5]; F.conv_w = args.in[6]; F.conv_b = args.in[7];
    F.ln_g = args.in[8]; F.ln_b = args.in[9]; F.og = args.in[10]; F.w_out = args.in[11]; F.g2 = args.in[12]; F.w_r = args.in[13]; F.b_r = args.in[14];
    F.w_up = args.in[15]; F.b_up = args.in[16]; F.w_dn = args.in[17]; F.b_dn = args.in[18]; F.out = args.out;
    F.WinT = (bf16*)(ws + WS_WIN); F.WoT = (bf16*)(ws + WS_WO); F.WdT = ws + WS_WD; F.WupT = ws + WS_WUP; F.NM = (bf16*)(ws + WS_NM);
    F.Q = (bf16*)(ws + WS_Q); F.Kh = (bf16*)(ws + WS_K); F.VT = (bf16*)(ws + WS_VT); F.HCV = (bf16*)(ws + WS_HCV); F.HN = ws + WS_HN; F.ACT = ws + WS_ACT; F.Y = ws + WS_Y;
    F.rtok = (int*)(ws + WS_RTOK); F.rgate = (float*)(ws + WS_RGATE); F.tslot = (unsigned*)(ws + WS_TSLOT); F.rfrag = ws + WS_RFRAG;
    for (int u = F.tid; u < 512 / 4; u += NWAVES * 64) ((LAS unsigned*)(F.lds + LDSCTL_OFF))[u] = 0u;
    __syncthreads();
    XcdBarrier bar; bar.bar = (unsigned*)(F.ctl + CW_BAR); bar.x = 0; bar.st = nullptr;
    if (PHI - PLO > 1) bar = xcd_barrier_post((unsigned*)(F.ctl + CW_BAR), (volatile LAS unsigned*)(F.lds + MISC_OFF) + 8);
    constexpr int lo = PLO, hi = PHI;
#ifndef PH_MASK
#define PH_MASK 0xff
#endif
#define IN(k) (((PH_MASK >> (k)) & 1) && lo <= (k) && (k) < hi)
#define SEAM(k) do { if (IN(k) && IN((k) + 1)) xcd_barrier(bar); } while (0)
    bool moe_ready = false;
#define FRESH() do { int t_ = threadIdx.x; asm volatile("" : "+v"(t_)); F.tid = t_; F.lane = t_ & 63; F.wave = __builtin_amdgcn_readfirstlane(t_ >> 6); } while (0)

    if (IN(0)) { FRESH(); p0_prologue<7>(F); if (NREP(0) > 1) { __syncthreads(); FRESH(); p0_prologue<(NREP(0) == 2 ? 7 : NREP(0) == 3 ? 2 : NREP(0) == 4 ? 4 : 1)>(F); } SEAM(0); }
    if (IN(1)) { FRESH();
        pg8::StaticSched S; S.init(NTOK, INC, DM, F.WinT, F.G, (int)blockIdx.x);
        pg8::EpiIn E{F.Q, F.Kh, F.VT, F.HCV, F.qg, F.kg};
        pg8::gemm_phase(F.lds, (const char*)F.NM, DM * 2, S, E, F.tid); if (NREP(1) > 1) { FRESH(); pg8::gemm_phase(F.lds, (const char*)F.NM, DM * 2, S, E, F.tid); }
        SEAM(1);
    }
    if (IN(2)) { FRESH(); conv_phase(F); if (NREP(2) > 1) { __syncthreads(); FRESH(); conv_phase(F); } __syncthreads(); attn_phase(F); if (NREP(7) > 1) { __syncthreads(); FRESH(); attn_phase(F); } SEAM(2); }
    if (IN(3)) { FRESH();
        pg8::StaticSched S; S.init(NTOK, DM, DM, F.WoT, F.G, (int)blockIdx.x);
        pg8::EpiRes E{F.x, F.out};
        pg8::gemm_phase(F.lds, (const char*)F.NM, DM * 2, S, E, F.tid); if (NREP(3) > 1) { FRESH(); pg8::gemm_phase(F.lds, (const char*)F.NM, DM * 2, S, E, F.tid); }
        SEAM(3);
    }
    if (IN(4)) { FRESH(); if (NREP(4) > 1) { router_phase<(NREP(4) > 1 ? (int)NREP(4) - 2 : 0)>(F, false); __syncthreads(); FRESH(); } router_phase<0>(F, true); SEAM(4); }
    if (IN(5)) { FRESH();
        if (!moe_ready) { moe_setup(F); moe_ready = true; }
        const LAS int* tpre = (const LAS int*)(F.aux + A_TPRE); const LAS int* cnt = (const LAS int*)(F.aux + A_CNT);
        LAS unsigned* idx = (LAS unsigned*)(F.aux + A_IDX);
        pg8::MoeSched<true> S; S.G = F.G; S.v = F.vcu; S.NT = 8; S.ntot = tpre[NE]; S.K2 = 1024u; S.Bt = (const char*)F.WupT; S.bstride = (size_t)2048 * 1024; S.tpre = tpre; S.idx = idx;
        { unsigned tkv[MAXU];
#pragma unroll
          for (int i = 0; i < MAXU; ++i) { pg8::Unit u; const bool ok = S.next(i, u); const int lr = u.rt * 256 + (F.tid & 255);
              tkv[i] = (ok && F.tid < 256 && lr < cnt[u.e]) ? (unsigned)F.rtok[(size_t)u.e * CAP + lr] : 0u; }
#pragma unroll
          for (int i = 0; i < MAXU; ++i) if (F.tid < 256) idx[i * 256 + F.tid] = tkv[i] * 1024u; }
        __syncthreads();
        pg8::EpiUp E{F.ACT, F.b_up};
        pg8::gemm_phase(F.lds, (const char*)F.HN, DM, S, E, F.tid); if (NREP(5) > 1) { FRESH(); pg8::gemm_phase(F.lds, (const char*)F.HN, DM, S, E, F.tid); }
        SEAM(5);
    }
    if (IN(6)) { FRESH();
        if (!moe_ready) { moe_setup(F); moe_ready = true; }
        const LAS int* tpre = (const LAS int*)(F.aux + A_TPRE);
        pg8::MoeSched<false> S; S.G = F.G; S.v = F.vcu; S.NT = 4; S.ntot = tpre[NE]; S.K2 = 1024u; S.Bt = (const char*)F.WdT; S.bstride = (size_t)1024 * 1024; S.tpre = tpre; S.idx = nullptr;
        pg8::EpiDown E{F.Y, F.b_dn, F.rgate};
        pg8::gemm_phase(F.lds, (const char*)F.ACT, DE, S, E, F.tid); if (NREP(6) > 1) { FRESH(); pg8::gemm_phase(F.lds, (const char*)F.ACT, DE, S, E, F.tid); }
        SEAM(6);
    }
    if (IN(7)) { FRESH();
        if (!moe_ready) { moe_setup(F); moe_ready = true; }
        if (PROBE_P7) { combine_phase(F, (float*)(ws + WS_ACT)); __syncthreads(); FRESH(); }
        combine_phase(F, F.out);
    }
#undef IN
#undef SEAM
}

template <int PLO, int PHI> static bool launch_range(int& grid, const Args& a, hipStream_t stream) {
    static bool ready = false;
    if (!ready) {
        int dev = 0, cus = 0, per_cu = 0;
        if (hipGetDevice(&dev) != hipSuccess || hipDeviceGetAttribute(&cus, hipDeviceAttributeMultiprocessorCount, dev) != hipSuccess) return false;
        if (hipFuncSetAttribute((const void*)hymba_fwd<PLO, PHI>, hipFuncAttributeMaxDynamicSharedMemorySize, LDS_BYTES) != hipSuccess) { fprintf(stderr, "kernel_launch: hipFuncSetAttribute failed\n"); return false; }
        if (hipOccupancyMaxActiveBlocksPerMultiprocessor(&per_cu, (const void*)hymba_fwd<PLO, PHI>, NWAVES * 64, LDS_BYTES) != hipSuccess || per_cu < 1) fprintf(stderr, "kernel_launch: occupancy query says %d\n", per_cu);
        (void)hipGetLastError();
        grid = cus;
        ready = true;
    }
    hipLaunchKernelGGL((hymba_fwd<PLO, PHI>), dim3(grid), dim3(NWAVES * 64), LDS_BYTES, stream, a);
    return true;
}
extern "C" void kernel_launch(void* const* d_in, const int* in_sizes, int n_in, void* d_out, int out_size, void* d_ws, size_t ws_size, hipStream_t stream) {
    static int grid = 0;
    if (grid < 0) return;
    if (n_in != 19 || in_sizes[0] != NTOK * DM || out_size != NTOK * DM || ws_size < WS_END) { fprintf(stderr, "kernel_launch: unexpected shapes (n_in %d, ws %zu); nothing launched\n", n_in, ws_size); grid = -1; return; }
    if (hipMemsetAsync((char*)d_ws + WS_CTL, 0, CTL_ZERO_BYTES, stream) != hipSuccess) return;
    Args a{};
    for (int i = 0; i < 19; ++i) a.in[i] = (const float*)d_in[i];
    a.out = (float*)d_out; a.ws = (unsigned char*)d_ws; a.ph_lo = 0; a.ph_hi = 8;
#if MK_N_LAUNCHES == 1
    if (!launch_range<0, 8>(grid, a, stream)) grid = -1;
#else
    bool ok = launch_range<0, 1>(grid, a, stream) && launch_range<1, 2>(grid, a, stream) && launch_range<2, 3>(grid, a, stream) && launch_range<3, 4>(grid, a, stream)
           && launch_range<4, 5>(grid, a, stream) && launch_range<5, 6>(grid, a, stream) && launch_range<6, 7>(grid, a, stream) && launch_range<7, 8>(grid, a, stream);
    if (!ok) grid = -1;
#endif
}
```
